# Optimizing an MI355X kernel written in HIP

```python
import math
import jax
import jax.numpy as jnp
from jax import lax
import numpy as np

D_MODEL = 1024
BATCH = 4
SEQ = 8192
DEPTH = 2

GRID_W = 64
CTX_LEN = 256
Q_BLOCK = 128
ROPE_THETA = 10000.0
NORM_EPS = 1e-6

SSD_INNER = D_MODEL // 2
SSD_HEAD_DIM = 64
SSD_HEADS = SSD_INNER // SSD_HEAD_DIM
SSD_GROUPS = 2
SSD_STATE = 64
SSD_CHUNK = 128
SSD_CONV_W = 5
SSD_CONV_CH = SSD_INNER + 2 * SSD_GROUPS * SSD_STATE

DIFF_HEADS = 4
DIFF_HD = 64
DIFF_QK = DIFF_HEADS * 2 * DIFF_HD
DIFF_WIDTH = DIFF_HEADS * 2 * DIFF_HD

GQA_HEADS = 8
GQA_KV_HEADS = 2
GQA_HD = 64
GQA_WIDTH = GQA_HEADS * GQA_HD
GQA_KV_WIDTH = GQA_KV_HEADS * GQA_HD

S5_GROUP_CH = 16
S5_STATE = 64
S5_WIDTH = 3 * D_MODEL // 8
S5_GROUPS = S5_WIDTH // S5_GROUP_CH

FFN_HIDDEN = -(-8 * D_MODEL // (3 * 256)) * 256

N_BRANCHES = 4
IN_SPLITS = (SSD_INNER + SSD_CONV_CH + 2 * SSD_HEADS,
             2 * DIFF_QK + DIFF_WIDTH,
             GQA_WIDTH + 2 * GQA_KV_WIDTH,
             S5_WIDTH)
IN_COLS = sum(IN_SPLITS)

kernel_name = 'hybrid_flow_backbone_block'


def split_cols(x, sizes):
    return jnp.split(x, np.cumsum(sizes)[:-1].tolist(), axis=-1)


def rms_norm(x, g):
    xf = x.astype(jnp.float32)
    y = xf * lax.rsqrt(jnp.mean(xf * xf, axis=-1, keepdims=True) + NORM_EPS)
    return (y * g.astype(jnp.float32)).astype(x.dtype)


def modulate(x, shift, scale):
    return x * (1.0 + scale) + shift


def swiglu(x, w_gate_up, w_down):
    gate, up = jnp.split(x @ w_gate_up, 2, axis=-1)
    return (jax.nn.silu(gate) * up) @ w_down


def _flip(t, direction):
    return jnp.flip(t, axis=1) if direction == 1 else t


def axial_rope_tables(n_tokens, head_dim):
    n_rows = n_tokens // GRID_W
    rows = jnp.repeat(jnp.arange(n_rows, dtype=jnp.float32), GRID_W)
    cols = jnp.tile(jnp.arange(GRID_W, dtype=jnp.float32), n_rows)
    quarter = head_dim // 4
    inv_freq = ROPE_THETA ** (-jnp.arange(quarter, dtype=jnp.float32) / quarter)
    ang_r = rows[:, None] * inv_freq
    ang_c = cols[:, None] * inv_freq
    ang = jnp.concatenate([ang_r, ang_r, ang_c, ang_c], axis=-1)
    return jnp.cos(ang), jnp.sin(ang)


def apply_axial_rope(x, cos, sin):
    r1, r2, c1, c2 = jnp.split(x, 4, axis=-1)
    rotated = jnp.concatenate([-r2, r1, -c2, c1], axis=-1)
    out = x * cos[None, :, None, :].astype(x.dtype) + rotated * sin[None, :, None, :].astype(x.dtype)
    return out.astype(x.dtype)


def sweep_query_blocks(block_fn, q):
    bsz, n = q.shape[:2]
    nb = n // Q_BLOCK
    qb = jnp.moveaxis(q.reshape((bsz, nb, Q_BLOCK) + q.shape[2:]), 1, 0)
    out = lax.map(block_fn, qb)
    return jnp.moveaxis(out, 0, 1).reshape((bsz, n) + out.shape[3:])


def depthwise_conv_centred(x, w, b):
    k = w.shape[0]
    pad = (k - 1) // 2
    y = lax.conv_general_dilated(x, w[:, None, :].astype(x.dtype), window_strides=(1,),
                                 padding=[(pad, pad)], dimension_numbers=('NWC', 'WIO', 'NWC'),
                                 feature_group_count=x.shape[-1])
    return y + b.astype(x.dtype)


def ssd_chunked_scan(xs, dt, a_neg, bs, cs, h0):
    bsz, n, nh, hp = xs.shape
    nc = n // SSD_CHUNK
    rep = nh // SSD_GROUPS
    bh = jnp.repeat(bs, rep, axis=2).reshape(bsz, nc, SSD_CHUNK, nh, SSD_STATE)
    ch = jnp.repeat(cs, rep, axis=2).reshape(bsz, nc, SSD_CHUNK, nh, SSD_STATE)
    xq = xs.reshape(bsz, nc, SSD_CHUNK, nh, hp)
    dtq = dt.reshape(bsz, nc, SSD_CHUNK, nh)
    a = jnp.moveaxis((dtq.astype(jnp.float32) * a_neg), 3, 1)
    a_cum = jnp.cumsum(a, axis=-1)
    lower = jnp.tril(jnp.ones((SSD_CHUNK, SSD_CHUNK), dtype=bool))
    seg = a_cum[..., :, None] - a_cum[..., None, :]
    decay = jnp.exp(jnp.where(lower, seg, -jnp.inf))
    xdt = xq * dtq[..., None]
    scores = jnp.einsum('bcqhn,bckhn->bhcqk', ch, bh) * decay
    y_diag = jnp.einsum('bhcqk,bckhp->bcqhp', scores, xdt)
    decay_to_end = jnp.exp(a_cum[..., -1:] - a_cum)
    states = jnp.einsum('bhck,bckhn,bckhp->cbhpn', decay_to_end, bh, xdt)
    chunk_decay = jnp.moveaxis(jnp.exp(a_cum[..., -1]), 2, 0)

    def carry_step(h, inp):
        s, d = inp
        return h * d[..., None, None] + s, h

    h_final, h_start = lax.scan(carry_step, h0, (states, chunk_decay))
    y_off = jnp.einsum('bcqhn,cbhpn,bhcq->bcqhp', ch, h_start, jnp.exp(a_cum))
    return (y_diag + y_off).reshape(bsz, n, nh, hp), h_final


def ssd_mixer(p_ctx, p_lat, conv_w, conv_b, a_log, dt_bias, d_skip, norm_g, ctx_out):
    def prep(p):
        bsz, n = p.shape[:2]
        z, xbc, dt_raw = split_cols(p, (SSD_INNER, SSD_CONV_CH, 2 * SSD_HEADS))
        xbc = jax.nn.silu(depthwise_conv_centred(xbc, conv_w, conv_b))
        xs, bs, cs = split_cols(xbc, (SSD_INNER, SSD_GROUPS * SSD_STATE, SSD_GROUPS * SSD_STATE))
        return (z, xs.reshape(bsz, n, SSD_HEADS, SSD_HEAD_DIM),
                bs.reshape(bsz, n, SSD_GROUPS, SSD_STATE),
                cs.reshape(bsz, n, SSD_GROUPS, SSD_STATE),
                dt_raw.reshape(bsz, n, 2, SSD_HEADS))

    zc, xc, bc, cc, dtc = prep(p_ctx)
    zl, xl, bl, cl, dtl = prep(p_lat)
    y_lat = d_skip[:, None] * xl
    y_ctx = d_skip[:, None] * xc
    for direction in range(2):
        a_neg = -jnp.exp(a_log[direction].astype(jnp.float32))
        dt_c = jax.nn.softplus((dtc[:, :, direction] + dt_bias[direction]).astype(jnp.float32))
        dt_l = jax.nn.softplus((dtl[:, :, direction] + dt_bias[direction]).astype(jnp.float32))
        h0 = jnp.zeros((xc.shape[0], SSD_HEADS, SSD_HEAD_DIM, SSD_STATE), jnp.float32)
        yc, hc = ssd_chunked_scan(_flip(xc, direction), _flip(dt_c, direction), a_neg,
                                  _flip(bc, direction), _flip(cc, direction), h0)
        yl, _ = ssd_chunked_scan(_flip(xl, direction), _flip(dt_l, direction), a_neg,
                                 _flip(bl, direction), _flip(cl, direction), hc)
        y_lat = y_lat + _flip(yl, direction)
        if ctx_out:
            y_ctx = y_ctx + _flip(yc, direction)

    def finish(y, z):
        bsz, n = y.shape[:2]
        y = y.reshape(bsz, n, SSD_INNER)
        return rms_norm(y * jax.nn.silu(z), norm_g).astype(z.dtype)

    return finish(y_lat, zl), (finish(y_ctx, zc) if ctx_out else None)


def diff_attention_mixer(p_ctx, p_lat, cos, sin, qn_g, kn_g, lam_q1, lam_k1, lam_q2, lam_k2,
                         subln_g, lam_init, ctx_out):
    def prep(p, rope):
        bsz, n = p.shape[:2]
        q, k, v = split_cols(p, (DIFF_QK, DIFF_QK, DIFF_WIDTH))
        q = rms_norm(q.reshape(bsz, n, 2 * DIFF_HEADS, DIFF_HD), qn_g)
        k = rms_norm(k.reshape(bsz, n, 2 * DIFF_HEADS, DIFF_HD), kn_g)
        if rope:
            q = apply_axial_rope(q, cos, sin)
            k = apply_axial_rope(k, cos, sin)
        return (q.reshape(bsz, n, DIFF_HEADS, 2, DIFF_HD), k.reshape(bsz, n, DIFF_HEADS, 2, DIFF_HD),
                v.reshape(bsz, n, DIFF_HEADS, 2 * DIFF_HD))

    f32 = jnp.float32
    lam = (jnp.exp(jnp.sum(lam_q1.astype(f32) * lam_k1.astype(f32)))
           - jnp.exp(jnp.sum(lam_q2.astype(f32) * lam_k2.astype(f32))) + lam_init)
    qc, kc, vc = prep(p_ctx, False)
    ql, kl, vl = prep(p_lat, True)
    k_all = jnp.concatenate([kc, kl], axis=1)
    v_all = jnp.concatenate([vc, vl], axis=1)
    scale = DIFF_HD ** -0.5

    def block(qb, k, v):
        s = jnp.einsum('bqhmd,bkhmd->bhmqk', qb, k).astype(f32) * scale
        p = jax.nn.softmax(s, axis=-1)
        a = p[:, :, 0] - lam * p[:, :, 1]
        return jnp.einsum('bhqk,bkhe->bqhe', a.astype(v.dtype), v)

    def finish(o):
        bsz, n = o.shape[:2]
        o = rms_norm(o, subln_g) * (1.0 - lam_init)
        return o.reshape(bsz, n, DIFF_WIDTH)

    out_lat = finish(sweep_query_blocks(lambda qb: block(qb, k_all, v_all), ql))
    out_ctx = finish(block(qc, kc, vc)) if ctx_out else None
    return out_lat, out_ctx


def gqa_mixer(p_ctx, p_lat, cos, sin, qn_g, kn_g, ctx_out):
    def prep(p, rope):
        bsz, n = p.shape[:2]
        q, k, v = split_cols(p, (GQA_WIDTH, GQA_KV_WIDTH, GQA_KV_WIDTH))
        q = rms_norm(q.reshape(bsz, n, GQA_HEADS, GQA_HD), qn_g)
        k = rms_norm(k.reshape(bsz, n, GQA_KV_HEADS, GQA_HD), kn_g)
        v = v.reshape(bsz, n, GQA_KV_HEADS, GQA_HD)
        if rope:
            q = apply_axial_rope(q, cos, sin)
            k = apply_axial_rope(k, cos, sin)
        q = q.reshape(bsz, n, GQA_KV_HEADS, GQA_HEADS // GQA_KV_HEADS, GQA_HD)
        return q, k, v

    qc, kc, vc = prep(p_ctx, False)
    ql, kl, vl = prep(p_lat, True)
    k_all = jnp.concatenate([kc, kl], axis=1)
    v_all = jnp.concatenate([vc, vl], axis=1)
    scale = GQA_HD ** -0.5

    def block(qb, k, v):
        s = jnp.einsum('bqngd,bsnd->bngqs', qb, k).astype(jnp.float32) * scale
        p = jax.nn.softmax(s, axis=-1).astype(v.dtype)
        return jnp.einsum('bngqs,bsnd->bqngd', p, v)

    def finish(o):
        bsz, n = o.shape[:2]
        return o.reshape(bsz, n, GQA_WIDTH)

    out_lat = finish(sweep_query_blocks(lambda qb: block(qb, k_all, v_all), ql))
    out_ctx = finish(block(qc, kc, vc)) if ctx_out else None
    return out_lat, out_ctx


def s5_discretise(lam_re, lam_im, log_dt, b_re, b_im):
    f32 = jnp.float32
    lr, li = lam_re.astype(f32), lam_im.astype(f32)
    step = jnp.exp(log_dt.astype(f32))[:, None]
    mag = jnp.exp(lr * step)
    ar, ai = mag * jnp.cos(li * step), mag * jnp.sin(li * step)
    den = lr * lr + li * li
    fr = ((ar - 1.0) * lr + ai * li) / den
    fi = (ai * lr - (ar - 1.0) * li) / den
    br, bi = b_re.astype(f32), b_im.astype(f32)
    bbr = fr[..., None] * br - fi[..., None] * bi
    bbi = fr[..., None] * bi + fi[..., None] * br
    return ar, ai, bbr, bbi


def complex_affine_combine(e1, e2):
    a1r, a1i, b1r, b1i = e1
    a2r, a2i, b2r, b2i = e2
    ar = a1r * a2r - a1i * a2i
    ai = a1r * a2i + a1i * a2r
    br = a2r * b1r - a2i * b1i + b2r
    bi = a2r * b1i + a2i * b1r + b2i
    return ar, ai, br, bi


def s5_states(u, ar, ai, bbr, bbi, h0r, h0i):
    bsz, n = u.shape[:2]
    ug = jnp.moveaxis(u.reshape(bsz, n, S5_GROUPS, S5_GROUP_CH), 1, 0).astype(jnp.float32)
    bur = jnp.einsum('gpc,lbgc->lbgp', bbr, ug)
    bui = jnp.einsum('gpc,lbgc->lbgp', bbi, ug)
    bur = bur.at[0].add(ar * h0r - ai * h0i)
    bui = bui.at[0].add(ar * h0i + ai * h0r)
    a_r = jnp.broadcast_to(ar, (n, 1) + ar.shape)
    a_i = jnp.broadcast_to(ai, (n, 1) + ai.shape)
    _, _, hr, hi = lax.associative_scan(complex_affine_combine, (a_r, a_i, bur, bui), axis=0)
    return hr, hi


def s5_readout(hr, hi, c_re, c_im):
    n, bsz = hr.shape[:2]
    y = (jnp.einsum('gcp,lbgp->blgc', c_re.astype(jnp.float32), hr)
         - jnp.einsum('gcp,lbgp->blgc', c_im.astype(jnp.float32), hi))
    return y.reshape(bsz, n, S5_WIDTH)


def s5_mixer(u_ctx, u_lat, lam_re, lam_im, log_dt, b_re, b_im, c_re, c_im, d_skip,
             glu_w, glu_b, ctx_out):
    y_lat = d_skip * u_lat
    y_ctx = d_skip * u_ctx
    for direction in range(2):
        ar, ai, bbr, bbi = s5_discretise(lam_re[direction], lam_im[direction], log_dt[direction], b_re, b_im)
        zero = jnp.zeros((u_ctx.shape[0], S5_GROUPS, S5_STATE), jnp.float32)
        cr, ci = s5_states(_flip(u_ctx, direction), ar, ai, bbr, bbi, zero, zero)
        lr_, li_ = s5_states(_flip(u_lat, direction), ar, ai, bbr, bbi, cr[-1], ci[-1])
        y_lat = y_lat + _flip(s5_readout(lr_, li_, c_re, c_im), direction)
        if ctx_out:
            y_ctx = y_ctx + _flip(s5_readout(cr, ci, c_re, c_im), direction)

    def glu(y, dtype):
        val, gate = jnp.split(jax.nn.gelu(y) @ glu_w + glu_b, 2, axis=-1)
        return (val * jax.nn.sigmoid(gate)).astype(dtype)

    return glu(y_lat, u_lat.dtype), (glu(y_ctx, u_ctx.dtype) if ctx_out else None)


def merge_branches(xn, ys, w_gate_l, w_brs, w_out_l):
    merged = None
    for i in range(N_BRANCHES):
        term = jax.nn.sigmoid(xn @ w_gate_l[i]) * (ys[i] @ w_brs[i])
        merged = term if merged is None else merged + term
    return merged @ w_out_l


def setup_inputs(seed: int = 0) -> dict:
    key = jax.random.key(seed)
    ks = iter(jax.random.split(key, 64))
    f32 = jnp.float32
    D = D_MODEL
    L = DEPTH

    def nrm(shape, scale):
        return jax.random.normal(next(ks), shape, f32) * scale

    def gain(shape):
        return 1.0 + nrm(shape, 0.05)

    ssd_a_log = jnp.log(jax.random.uniform(next(ks), (L, 2, SSD_HEADS), f32, 1.0, 16.0))
    dt0 = jnp.exp(jax.random.uniform(next(ks), (L, 2, SSD_HEADS), f32, math.log(1e-3), math.log(1e-1)))
    ssd_dt_bias = dt0 + jnp.log(-jnp.expm1(-dt0))
    n_idx = jnp.arange(S5_STATE, dtype=f32)
    s5_lam_re = -0.5 + nrm((L, 2, S5_GROUPS, S5_STATE), 0.01)
    s5_lam_im = math.pi * n_idx + nrm((L, 2, S5_GROUPS, S5_STATE), 0.01)
    s5_log_dt = jax.random.uniform(next(ks), (L, 2, S5_GROUPS), f32, math.log(1e-3), math.log(1e-1))
    b_scale = (2.0 * S5_GROUP_CH) ** -0.5
    c_scale = (2.0 * S5_STATE) ** -0.5
    return {
        'x': nrm((BATCH, SEQ, D), 1.0),
        'c': nrm((BATCH, D), 1.0),
        'ctx': nrm((BATCH, CTX_LEN, D), 1.0),
        'c_ctx': nrm((D,), 1.0),
        'w_mod': nrm((L, D, 6 * D), 0.5 * D ** -0.5),
        'b_mod': nrm((L, 6 * D), 0.01),
        'norm1_g': gain((L, D)),
        'norm2_g': gain((L, D)),
        'w_in': nrm((L, D, IN_COLS), D ** -0.5),
        'ssd_conv_w': nrm((L, SSD_CONV_W, SSD_CONV_CH), SSD_CONV_W ** -0.5),
        'ssd_conv_b': nrm((L, SSD_CONV_CH), 0.01),
        'ssd_a_log': ssd_a_log,
        'ssd_dt_bias': ssd_dt_bias,
        'ssd_d': gain((L, SSD_HEADS)),
        'ssd_norm_g': gain((L, SSD_INNER)),
        'diff_qn_g': gain((L, DIFF_HD)),
        'diff_kn_g': gain((L, DIFF_HD)),
        'diff_lam_q1': nrm((L, DIFF_HD), 0.1),
        'diff_lam_k1': nrm((L, DIFF_HD), 0.1),
        'diff_lam_q2': nrm((L, DIFF_HD), 0.1),
        'diff_lam_k2': nrm((L, DIFF_HD), 0.1),
        'diff_subln_g': gain((L, 2 * DIFF_HD)),
        'gqa_qn_g': gain((L, GQA_HD)),
        'gqa_kn_g': gain((L, GQA_HD)),
        's5_lam_re': s5_lam_re,
        's5_lam_im': s5_lam_im,
        's5_log_dt': s5_log_dt,
        's5_b_re': nrm((L, S5_GROUPS, S5_STATE, S5_GROUP_CH), b_scale),
        's5_b_im': nrm((L, S5_GROUPS, S5_STATE, S5_GROUP_CH), b_scale),
        's5_c_re': nrm((L, S5_GROUPS, S5_GROUP_CH, S5_STATE), c_scale),
        's5_c_im': nrm((L, S5_GROUPS, S5_GROUP_CH, S5_STATE), c_scale),
        's5_d': nrm((L, S5_WIDTH), 1.0),
        's5_glu_w': nrm((L, S5_WIDTH, 2 * S5_WIDTH), S5_WIDTH ** -0.5),
        's5_glu_b': nrm((L, 2 * S5_WIDTH), 0.01),
        'w_gate': nrm((L, N_BRANCHES, D, D), D ** -0.5),
        'w_br_ssd': nrm((L, SSD_INNER, D), SSD_INNER ** -0.5),
        'w_br_diff': nrm((L, DIFF_WIDTH, D), DIFF_WIDTH ** -0.5),
        'w_br_gqa': nrm((L, GQA_WIDTH, D), GQA_WIDTH ** -0.5),
        'w_br_s5': nrm((L, S5_WIDTH, D), S5_WIDTH ** -0.5),
        'w_out': nrm((L, D, D), D ** -0.5),
        'ffn_w_gate_up': nrm((L, D, 2 * FFN_HIDDEN), D ** -0.5),
        'ffn_w_down': nrm((L, FFN_HIDDEN, D), FFN_HIDDEN ** -0.5),
    }


def reference(x, c, ctx, c_ctx, w_mod, b_mod, norm1_g, norm2_g, w_in,
              ssd_conv_w, ssd_conv_b, ssd_a_log, ssd_dt_bias, ssd_d, ssd_norm_g,
              diff_qn_g, diff_kn_g, diff_lam_q1, diff_lam_k1, diff_lam_q2, diff_lam_k2, diff_subln_g,
              gqa_qn_g, gqa_kn_g,
              s5_lam_re, s5_lam_im, s5_log_dt, s5_b_re, s5_b_im, s5_c_re, s5_c_im, s5_d,
              s5_glu_w, s5_glu_b,
              w_gate, w_br_ssd, w_br_diff, w_br_gqa, w_br_s5, w_out,
              ffn_w_gate_up, ffn_w_down):
    n_tok = x.shape[1]
    cos, sin = axial_rope_tables(n_tok, GQA_HD)
    h_lat, h_ctx = x, ctx
    for layer in range(DEPTH):
        ctx_out = layer < DEPTH - 1
        mod_lat = jax.nn.silu(c) @ w_mod[layer] + b_mod[layer]
        mod_ctx = jax.nn.silu(c_ctx) @ w_mod[layer] + b_mod[layer]
        sh1, sc1, g1, sh2, sc2, g2 = jnp.split(mod_lat[:, None, :], 6, axis=-1)
        csh1, csc1, cg1, csh2, csc2, cg2 = jnp.split(mod_ctx, 6, axis=-1)

        xn_lat = modulate(rms_norm(h_lat, norm1_g[layer]), sh1, sc1)
        xn_ctx = modulate(rms_norm(h_ctx, norm1_g[layer]), csh1, csc1)
        pa_l, pb_l, pc_l, pd_l = split_cols(xn_lat @ w_in[layer], IN_SPLITS)
        pa_c, pb_c, pc_c, pd_c = split_cols(xn_ctx @ w_in[layer], IN_SPLITS)

        ya_l, ya_c = ssd_mixer(pa_c, pa_l, ssd_conv_w[layer], ssd_conv_b[layer], ssd_a_log[layer],
                               ssd_dt_bias[layer], ssd_d[layer], ssd_norm_g[layer], ctx_out)
        lam_init = 0.8 - 0.6 * math.exp(-0.3 * layer)
        yb_l, yb_c = diff_attention_mixer(pb_c, pb_l, cos, sin, diff_qn_g[layer], diff_kn_g[layer],
                                          diff_lam_q1[layer], diff_lam_k1[layer], diff_lam_q2[layer],
                                          diff_lam_k2[layer], diff_subln_g[layer], lam_init, ctx_out)
        yc_l, yc_c = gqa_mixer(pc_c, pc_l, cos, sin, gqa_qn_g[layer], gqa_kn_g[layer], ctx_out)
        yd_l, yd_c = s5_mixer(pd_c, pd_l, s5_lam_re[layer], s5_lam_im[layer], s5_log_dt[layer],
                              s5_b_re[layer], s5_b_im[layer], s5_c_re[layer], s5_c_im[layer],
                              s5_d[layer], s5_glu_w[layer], s5_glu_b[layer], ctx_out)
        w_brs = (w_br_ssd[layer], w_br_diff[layer], w_br_gqa[layer], w_br_s5[layer])
        h_lat = h_lat + g1 * merge_branches(xn_lat, (ya_l, yb_l, yc_l, yd_l), w_gate[layer], w_brs, w_out[layer])

        xf_lat = modulate(rms_norm(h_lat, norm2_g[layer]), sh2, sc2)
        h_lat = h_lat + g2 * swiglu(xf_lat, ffn_w_gate_up[layer], ffn_w_down[layer])

        if ctx_out:
            h_ctx = h_ctx + cg1 * merge_branches(xn_ctx, (ya_c, yb_c, yc_c, yd_c), w_gate[layer], w_brs, w_out[layer])
            xf_ctx = modulate(rms_norm(h_ctx, norm2_g[layer]), csh2, csc2)
            h_ctx = h_ctx + cg2 * swiglu(xf_ctx, ffn_w_gate_up[layer], ffn_w_down[layer])
    return h_lat
```

```cpp
#include <hip/hip_runtime.h>
#include <hip/hip_cooperative_groups.h>
#include <hip/hip_bf16.h>
#include <cstdio>
#include <cstdint>
#include <cmath>
namespace cg = cooperative_groups;
extern __shared__ __attribute__((aligned(16))) unsigned char g_lds_[];
constexpr int LDS_WTAB_OFF = 152 * 1024 - 16 - 256;
__device__ __forceinline__ unsigned hw_wave_key() { return (unsigned)__builtin_amdgcn_s_getreg(0x2804) & 63u; }
__device__ __forceinline__ void otid_init() { const int t = threadIdx.x; if ((t & 63) == 0) *(volatile int*)(g_lds_ + LDS_WTAB_OFF + hw_wave_key() * 4) = t >> 6;
    if (t < 4) *(volatile unsigned*)(g_lds_ + LDS_WTAB_OFF - 16 + t * 4) = 0u;
    __syncthreads(); }
__device__ __forceinline__ int otid() {
    const int wv = *(const volatile int*)(g_lds_ + LDS_WTAB_OFF + hw_wave_key() * 4);
    int t = wv * 64 + (int)__builtin_amdgcn_mbcnt_hi(~0u, __builtin_amdgcn_mbcnt_lo(~0u, 0u));
    asm volatile("" : "+v"(t)); return t;
}
namespace pg8 {
#define PG8_LAS __attribute__((address_space(3)))
typedef unsigned short bf16_t;
typedef short bf16x8 __attribute__((ext_vector_type(8)));
typedef float f32x4 __attribute__((ext_vector_type(4)));
typedef unsigned u32x4 __attribute__((ext_vector_type(4)));
constexpr int BM = 256, BK = 64, HALF = 128, HTB = HALF * BK * 2  , STAGE_BYTES = 8 * HTB, NXCD = 8, WGM = 8;

__host__ __device__ __forceinline__ int lds_byte(int r, int c) { const int st = (r >> 4) * 2 + (c >> 5), rr = r & 15, cc = c & 31, ob = rr * 64 + cc * 2; return st * 1024 + (ob ^ (((ob >> 9) & 1) << 5)); }
__host__ __device__ __forceinline__ void stage_rc(int b, int& R, int& C) { const int st = b / 1024, sb = b % 1024, swz = sb ^ (((sb >> 9) & 1) << 5); R = (st >> 1) * 16 + swz / 64; C = (st & 1) * 32 + (swz % 64) / 2; }
__host__ __device__ __forceinline__ int perm32(int rho) { const int n = rho >> 4, i = rho & 15; return 8 * (i >> 2) + 4 * n + (i & 3); }

struct Unit { int pm, pn, aux; };
struct Gemm { const bf16_t* A; const bf16_t* Bt; int K, lda; };

struct StaticOrder {
    int nM, nN, nwg, G, c;
    __host__ __device__ void init(int M, int N, int G_, int c_) { nM = M / BM; nN = N / BM; nwg = nM * nN; G = G_; c = c_; }
    __host__ __device__ bool next(int i, Unit& u) const {
        const long L = (long)i * G + c; if (L >= nwg) return false;
        int wgid = (int)L; { const int q = nwg / NXCD, r = nwg % NXCD, xcd = wgid % NXCD, off = wgid / NXCD; wgid = (xcd < r ? xcd * (q + 1) : r * (q + 1) + (xcd - r) * q) + off; }
        const int nig = WGM * nN, gid = wgid / nig, fm = gid * WGM, gsz = (nM - fm) < WGM ? (nM - fm) : WGM;
        u.pm = fm + ((wgid % nig) % gsz); u.pn = (wgid % nig) / gsz; return true;
    }
    __device__ __forceinline__ void a_ready(const Unit&) const {}
    __device__ __forceinline__ void done(const Unit&) const {}
};

__device__ __forceinline__ unsigned cvt_pk_bf16(float lo, float hi) { unsigned r; asm volatile("v_cvt_pk_bf16_f32 %0, %1, %2" : "=v"(r) : "v"(lo), "v"(hi)); return r; }
typedef float f32x2 __attribute__((ext_vector_type(2)));
__device__ __forceinline__ f32x2 gelu_pk(f32x2 v) {
    const f32x2 av = __builtin_elementwise_abs(v), d = av * 0.2316418882f + 1.0f;
    f32x2 t; t.x = __builtin_amdgcn_rcpf(d.x); t.y = __builtin_amdgcn_rcpf(d.y);
    f32x2 q = t * 0.5307027145f + (-0.7265760135f); q = q * t + 0.7107068705f; q = q * t + (-0.142248368f); q = q * t + 0.127414796f; q = q * t;
    const f32x2 s = (v * v) * (-0.72134752044f);
    f32x2 e; e.x = __builtin_amdgcn_exp2f(s.x); e.y = __builtin_amdgcn_exp2f(s.y);
    const f32x2 m = v * (q * e), r = v - m;
    f32x2 o; o.x = v.x < 0.f ? m.x : r.x; o.y = v.y < 0.f ? m.y : r.y; return o;
}

template <int ACT  > struct EpiBf16 {
    static constexpr bool PERM = true, AFTER_DRAIN = false, BIAS_INIT = false; static_assert(ACT == 0 || ACT == 1, "EpiBf16: ACT is 0 (none) or 1 (gelu_pk)");
    bf16_t* O; int ldc; const float* bias; int split_cols; size_t split_stride; float scale0;
    __device__ __forceinline__ void operator()(const f32x4 (&acc)[2][2][4][2], const Unit& u, int wr, int wc, int fr, int fq) const {
        const int row0 = u.pm * BM + wr * 64 + fr; int colt = u.pn * BM; bf16_t* base = O;
        float sc = 1.f; if (split_cols) { const int t = colt / split_cols; base += (size_t)t * split_stride; colt -= t * split_cols; if (t == 0) sc = scale0; }
        const int col0 = colt + wc * 32 + 8 * fq, bcol0 = u.pn * BM + wc * 32 + 8 * fq;
        f32x4 bv[2][2];
#pragma unroll
        for (int bj = 0; bj < 2; ++bj)
#pragma unroll
            for (int n = 0; n < 2; ++n) bv[bj][n] = bias ? *(const f32x4*)(bias + bcol0 + bj * HALF + 4 * n) : (f32x4){0.f, 0.f, 0.f, 0.f};
#pragma unroll
        for (int ai = 0; ai < 2; ++ai)
#pragma unroll
            for (int m = 0; m < 4; ++m) { bf16_t* rowp = base + (size_t)(row0 + ai * HALF + m * 16) * ldc + col0;
#pragma unroll
                for (int bj = 0; bj < 2; ++bj) { f32x4 v0 = acc[ai][bj][m][0] + bv[bj][0], v1 = acc[ai][bj][m][1] + bv[bj][1];
                    if (ACT == 1) { f32x2 a = gelu_pk((f32x2){v0[0], v0[1]}), b = gelu_pk((f32x2){v0[2], v0[3]}), c = gelu_pk((f32x2){v1[0], v1[1]}), d = gelu_pk((f32x2){v1[2], v1[3]});
                        v0 = (f32x4){a.x, a.y, b.x, b.y}; v1 = (f32x4){c.x, c.y, d.x, d.y}; }
                    v0 = v0 * sc; v1 = v1 * sc; u32x4 w; w.x = cvt_pk_bf16(v0[0], v0[1]); w.y = cvt_pk_bf16(v0[2], v0[3]); w.z = cvt_pk_bf16(v1[0], v1[1]); w.w = cvt_pk_bf16(v1[2], v1[3]);
                    *(u32x4*)(rowp + bj * HALF) = w; } }
    }
};
template <class Epi, class Sched, bool ALIGN_EPI = false, bool SP2 = false>
__device__ __forceinline__ void gemm_phase(PG8_LAS unsigned char* lds, const Gemm g, const Sched& S, const Epi& E) {
    const int tid = otid(), wid = __builtin_amdgcn_readfirstlane(tid >> 6), lane = tid & 63, wr = wid >> 2, wc = wid & 3, fr = lane & 15, fq = lane >> 4;
    const int K = g.K, nt = K / BK;
    unsigned voffA[2], voffB[2];
#pragma unroll
    for (int i = 0; i < 2; ++i) { int R, C; stage_rc(tid * 16 + i * 8192, R, C); const int Rb = Epi::PERM ? ((R & ~31) + perm32(R & 31)) : R;
        voffA[i] = (unsigned)(R * g.lda + C) * 2u; voffB[i] = (unsigned)(Rb * K + C) * 2u; }
    const size_t kstep = (size_t)(BK * 2);
    const size_t hstepA = (size_t)HALF * g.lda * 2, hstepB = (size_t)HALF * K * 2;
    const size_t tstepA = 2 * hstepA, tstepB = 2 * hstepB;
    const unsigned ldsw = (unsigned)wid * 1024u;
    const int aoff = lds_byte(wr * 64 + fr, fq * 8), boff = lds_byte(wc * 32 + fr, fq * 8);
#define PG8_SA(b, h) (((b) * 2 + (h)) * HTB)
#define PG8_SB(b, h) ((4 + (b) * 2 + (h)) * HTB)
#define PG8_STAGE(bufoff, gbase, voff) do { _Pragma("unroll") for (int _i = 0; _i < 2; ++_i) \
        __builtin_amdgcn_global_load_lds((const unsigned*)((const char*)(gbase) + (voff)[_i]), (PG8_LAS unsigned*)(lds + (bufoff) + ldsw + _i * 8192), 16, 0, 0); } while (0)
#define PG8_LDA(dst, b, h) do { _Pragma("unroll") for (int m = 0; m < 4; ++m) _Pragma("unroll") for (int k = 0; k < 2; ++k) dst[m][k] = *(const PG8_LAS bf16x8*)(lds + PG8_SA(b, h) + aoff + m * 2048 + k * 1024); } while (0)
#define PG8_LDB(dst, b, h) do { _Pragma("unroll") for (int n = 0; n < 2; ++n) _Pragma("unroll") for (int k = 0; k < 2; ++k) dst[n][k] = *(const PG8_LAS bf16x8*)(lds + PG8_SB(b, h) + boff + n * 2048 + k * 1024); } while (0)
#define PG8_MMA(ai, bj, At, Bt) do { __builtin_amdgcn_s_setprio(1); _Pragma("unroll") for (int m = 0; m < 4; ++m) _Pragma("unroll") for (int n = 0; n < 2; ++n) _Pragma("unroll") for (int k = 0; k < 2; ++k) \
        acc[ai][bj][m][n] = __builtin_amdgcn_mfma_f32_16x16x32_bf16(Bt[n][k], At[m][k], acc[ai][bj][m][n], 0, 0, 0); __builtin_amdgcn_s_setprio(0); } while (0)
#define PG8_WAIT_V(n) asm volatile("s_waitcnt vmcnt(" #n ")" ::: "memory")
#define PG8_WAIT_L(n) asm volatile("s_waitcnt lgkmcnt(" #n ")" ::: "memory")
#define PG8_BAR __builtin_amdgcn_s_barrier()
#define PG8_SCHED __builtin_amdgcn_sched_barrier(0)
    Unit cur, nxt; int ui = 0;
    if (!S.next(0, cur)) return;
    f32x4 acc[2][2][4][2];
#pragma unroll
    for (int a = 0; a < 2; ++a)
#pragma unroll
        for (int b = 0; b < 2; ++b)
#pragma unroll
            for (int m = 0; m < 4; ++m)
#pragma unroll
                for (int n = 0; n < 2; ++n) acc[a][b][m][n] = (f32x4){0.f, 0.f, 0.f, 0.f};
    if constexpr (Epi::BIAS_INIT) E.init(acc, cur, wc, fq);
    bf16x8 At[4][2], B0[2][2], B1[2][2];
    const char* cA = (const char*)g.A + (size_t)cur.pm * tstepA; const char* cB = (const char*)g.Bt + (size_t)cur.pn * tstepB;
    S.a_ready(cur);
    if constexpr (SP2) {
        PG8_STAGE(PG8_SB(0, 0), cB, voffB); PG8_STAGE(PG8_SB(0, 1), cB + hstepB, voffB); PG8_STAGE(PG8_SA(0, 0), cA, voffA); PG8_STAGE(PG8_SA(0, 1), cA + hstepA, voffA);
        if (wr == 1) PG8_BAR;
        PG8_WAIT_V(2); PG8_BAR;
        PG8_STAGE(PG8_SB(1, 0), cB + kstep, voffB); PG8_STAGE(PG8_SA(1, 0), cA + kstep, voffA); PG8_STAGE(PG8_SB(1, 1), cB + hstepB + kstep, voffB);
        PG8_WAIT_V(6); PG8_BAR;
    } else {
        PG8_STAGE(PG8_SB(0, 0), cB, voffB); PG8_STAGE(PG8_SA(0, 0), cA, voffA); PG8_STAGE(PG8_SB(0, 1), cB + hstepB, voffB); PG8_STAGE(PG8_SA(0, 1), cA + hstepA, voffA);
        if (wr == 1) PG8_BAR;
        PG8_WAIT_V(4); PG8_BAR;
        PG8_STAGE(PG8_SB(1, 0), cB + kstep, voffB); PG8_STAGE(PG8_SA(1, 0), cA + kstep, voffA); PG8_STAGE(PG8_SB(1, 1), cB + hstepB + kstep, voffB);
        PG8_WAIT_V(6); PG8_BAR;
    }
    for (;;) {
        const bool has_next = S.next(ui + 1, nxt);
        const char* nA = has_next ? (const char*)g.A + (size_t)nxt.pm * tstepA : cA; const char* nB = has_next ? (const char*)g.Bt + (size_t)nxt.pn * tstepB : cB;
        for (int t = 0; t < nt; t += 2) {
            const bool last = (t == nt - 2);
            const char* a1 = cA + (size_t)(t + 1) * kstep;
            const char* a2 = last ? nA : cA + (size_t)(t + 2) * kstep; const char* b2 = last ? nB : cB + (size_t)(t + 2) * kstep;
            const char* a3 = a2 + kstep; const char* b3 = b2 + kstep;
            if (last && has_next) S.a_ready(nxt);
            if constexpr (SP2) {
            PG8_LDB(B0, 0, 0); PG8_LDB(B1, 0, 1); PG8_SCHED; PG8_LDA(At, 0, 0); PG8_STAGE(PG8_SA(1, 1), a1 + hstepA, voffA);
            PG8_WAIT_V(8); PG8_WAIT_L(0); PG8_BAR; PG8_MMA(0, 0, At, B0); PG8_MMA(0, 1, At, B1); PG8_BAR; PG8_SCHED;
            PG8_LDA(At, 0, 1); PG8_STAGE(PG8_SB(0, 0), b2, voffB); PG8_STAGE(PG8_SB(0, 1), b2 + hstepB, voffB); PG8_STAGE(PG8_SA(0, 0), a2, voffA);
            PG8_WAIT_V(8); PG8_WAIT_L(0); PG8_BAR; PG8_MMA(1, 0, At, B0); PG8_MMA(1, 1, At, B1); PG8_BAR; PG8_SCHED;
            PG8_LDB(B0, 1, 0); PG8_LDB(B1, 1, 1); PG8_SCHED; PG8_LDA(At, 1, 0); PG8_STAGE(PG8_SA(0, 1), a2 + hstepA, voffA);
            PG8_WAIT_V(8); PG8_WAIT_L(0); PG8_BAR; PG8_MMA(0, 0, At, B0); PG8_MMA(0, 1, At, B1); PG8_BAR; PG8_SCHED;
            PG8_LDA(At, 1, 1); PG8_STAGE(PG8_SB(1, 0), b3, voffB); PG8_STAGE(PG8_SB(1, 1), b3 + hstepB, voffB); PG8_STAGE(PG8_SA(1, 0), a3, voffA);
            PG8_WAIT_V(8); PG8_WAIT_L(0); PG8_BAR; PG8_MMA(1, 0, At, B0); PG8_MMA(1, 1, At, B1); PG8_BAR; PG8_SCHED;
            } else {
            PG8_LDB(B0, 0, 0); PG8_SCHED; PG8_LDA(At, 0, 0); PG8_STAGE(PG8_SA(1, 1), a1 + hstepA, voffA);
            PG8_WAIT_L(8); PG8_BAR; PG8_WAIT_L(0); PG8_MMA(0, 0, At, B0); PG8_BAR; PG8_SCHED;
            PG8_LDB(B1, 0, 1); PG8_STAGE(PG8_SB(0, 0), b2, voffB);
            PG8_BAR; PG8_WAIT_L(0); PG8_MMA(0, 1, At, B1); PG8_BAR;
            PG8_LDA(At, 0, 1); PG8_STAGE(PG8_SA(0, 0), a2, voffA);
            PG8_BAR; PG8_WAIT_L(0); PG8_MMA(1, 0, At, B0); PG8_BAR; PG8_SCHED;
            PG8_STAGE(PG8_SB(0, 1), b2 + hstepB, voffB);
            PG8_WAIT_V(6); PG8_BAR; PG8_MMA(1, 1, At, B1); PG8_BAR;
            PG8_LDB(B0, 1, 0); PG8_SCHED; PG8_LDA(At, 1, 0); PG8_STAGE(PG8_SA(0, 1), a2 + hstepA, voffA);
            PG8_WAIT_L(8); PG8_BAR; PG8_WAIT_L(0); PG8_MMA(0, 0, At, B0); PG8_BAR; PG8_SCHED;
            PG8_LDB(B1, 1, 1); PG8_STAGE(PG8_SB(1, 0), b3, voffB);
            PG8_BAR; PG8_WAIT_L(0); PG8_MMA(0, 1, At, B1); PG8_BAR;
            PG8_LDA(At, 1, 1); PG8_STAGE(PG8_SA(1, 0), a3, voffA);
            PG8_BAR; PG8_WAIT_L(0); PG8_MMA(1, 0, At, B0); PG8_BAR; PG8_SCHED;
            PG8_STAGE(PG8_SB(1, 1), b3 + hstepB, voffB);
            PG8_WAIT_V(6); PG8_BAR; PG8_MMA(1, 1, At, B1); PG8_BAR;
            }
        }
        if constexpr (ALIGN_EPI) { if (wr == 0) PG8_BAR; }
        if constexpr (!Epi::AFTER_DRAIN) { E(acc, cur, wr, wc, fr, fq); S.done(cur); }
        if (!has_next) break;
#pragma unroll
        for (int a = 0; a < 2; ++a)
#pragma unroll
            for (int b = 0; b < 2; ++b)
#pragma unroll
                for (int m = 0; m < 4; ++m)
#pragma unroll
                    for (int n = 0; n < 2; ++n) acc[a][b][m][n] = (f32x4){0.f, 0.f, 0.f, 0.f};
        if constexpr (Epi::BIAS_INIT) E.init(acc, nxt, wc, fq);
        cur = nxt; cA = nA; cB = nB; ++ui;
        if constexpr (ALIGN_EPI) { if (wr == 1) PG8_BAR; }
    }
    PG8_WAIT_V(0);
    if constexpr (!ALIGN_EPI) { if (wr == 0) PG8_BAR; }
    PG8_BAR;
    if constexpr (Epi::AFTER_DRAIN) { E.fused(acc, cur, wr, wc, fr, fq, lds, wid, lane); S.done(cur); }
#undef PG8_SA
#undef PG8_SB
#undef PG8_STAGE
#undef PG8_LDA
#undef PG8_LDB
#undef PG8_MMA
#undef PG8_WAIT_V
#undef PG8_WAIT_L
#undef PG8_BAR
#undef PG8_SCHED
}

template <class Epi, class Sched>
__device__ __forceinline__ void gemm_phase_h(PG8_LAS unsigned char* lds, const Sched& S, const Epi& E) {
    const int tid = otid(), wid = __builtin_amdgcn_readfirstlane(tid >> 6), lane = tid & 63, wr = wid >> 2, wc = wid & 3, fr = lane & 15, fq = lane >> 4;
    int sR[2], sC[2], sRb[2];
#pragma unroll
    for (int i = 0; i < 2; ++i) { stage_rc(tid * 16 + i * 8192, sR[i], sC[i]); sRb[i] = Epi::PERM ? ((sR[i] & ~31) + perm32(sR[i] & 31)) : sR[i]; }
    Unit cur, nxt; Gemm gc, gn; int ui = 0;
    if (!S.next(0, cur, gc)) return;
    unsigned voffA[2], voffB[2], voffAn[2], voffBn[2];
#pragma unroll
    for (int i = 0; i < 2; ++i) { voffA[i] = (unsigned)(sR[i] * gc.lda + sC[i]) * 2u; voffB[i] = (unsigned)(sRb[i] * gc.K + sC[i]) * 2u; voffAn[i] = voffA[i]; voffBn[i] = voffB[i]; }
    const size_t kstep = (size_t)(BK * 2);
    size_t hstepA = (size_t)HALF * gc.lda * 2, hstepB = (size_t)HALF * gc.K * 2, hstepAn = hstepA, hstepBn = hstepB;
    int nt = gc.K / BK;
    const unsigned ldsw = (unsigned)wid * 1024u;
    const int aoff = lds_byte(wr * 64 + fr, fq * 8), boff = lds_byte(wc * 32 + fr, fq * 8);
#define PG8_SA(b, h) (((b) * 2 + (h)) * HTB)
#define PG8_SB(b, h) ((4 + (b) * 2 + (h)) * HTB)
#define PG8_STAGE(bufoff, gbase, voff) do { _Pragma("unroll") for (int _i = 0; _i < 2; ++_i) \
        __builtin_amdgcn_global_load_lds((const unsigned*)((const char*)(gbase) + (voff)[_i]), (PG8_LAS unsigned*)(lds + (bufoff) + ldsw + _i * 8192), 16, 0, 0); } while (0)
#define PG8_LDA(dst, b, h) do { _Pragma("unroll") for (int m = 0; m < 4; ++m) _Pragma("unroll") for (int k = 0; k < 2; ++k) dst[m][k] = *(const PG8_LAS bf16x8*)(lds + PG8_SA(b, h) + aoff + m * 2048 + k * 1024); } while (0)
#define PG8_LDB(dst, b, h) do { _Pragma("unroll") for (int n = 0; n < 2; ++n) _Pragma("unroll") for (int k = 0; k < 2; ++k) dst[n][k] = *(const PG8_LAS bf16x8*)(lds + PG8_SB(b, h) + boff + n * 2048 + k * 1024); } while (0)
#define PG8_MMA(ai, bj, At, Bt) do { __builtin_amdgcn_s_setprio(1); _Pragma("unroll") for (int m = 0; m < 4; ++m) _Pragma("unroll") for (int n = 0; n < 2; ++n) _Pragma("unroll") for (int k = 0; k < 2; ++k) \
        acc[ai][bj][m][n] = __builtin_amdgcn_mfma_f32_16x16x32_bf16(Bt[n][k], At[m][k], acc[ai][bj][m][n], 0, 0, 0); __builtin_amdgcn_s_setprio(0); } while (0)
#define PG8_WAIT_V(n) asm volatile("s_waitcnt vmcnt(" #n ")" ::: "memory")
#define PG8_WAIT_L(n) asm volatile("s_waitcnt lgkmcnt(" #n ")" ::: "memory")
#define PG8_BAR __builtin_amdgcn_s_barrier()
#define PG8_SCHED __builtin_amdgcn_sched_barrier(0)
    f32x4 acc[2][2][4][2];
#pragma unroll
    for (int a = 0; a < 2; ++a)
#pragma unroll
        for (int b = 0; b < 2; ++b)
#pragma unroll
            for (int m = 0; m < 4; ++m)
#pragma unroll
                for (int n = 0; n < 2; ++n) acc[a][b][m][n] = (f32x4){0.f, 0.f, 0.f, 0.f};
    bf16x8 At[4][2], B0[2][2], B1[2][2];
    const char* cA = (const char*)gc.A + (size_t)cur.pm * 2 * hstepA; const char* cB = (const char*)gc.Bt + (size_t)cur.pn * 2 * hstepB;
    PG8_STAGE(PG8_SB(0, 0), cB, voffB); PG8_STAGE(PG8_SB(0, 1), cB + hstepB, voffB); PG8_STAGE(PG8_SA(0, 0), cA, voffA); PG8_STAGE(PG8_SA(0, 1), cA + hstepA, voffA);
    if (wr == 1) PG8_BAR;
    PG8_WAIT_V(2); PG8_BAR;
    PG8_STAGE(PG8_SB(1, 0), cB + kstep, voffB); PG8_STAGE(PG8_SA(1, 0), cA + kstep, voffA); PG8_STAGE(PG8_SB(1, 1), cB + hstepB + kstep, voffB);
    PG8_WAIT_V(6); PG8_BAR;
    for (;;) {
        const bool has_next = S.next(ui + 1, nxt, gn);
        const char* nA = cA; const char* nB = cB;
        if (has_next) { hstepAn = (size_t)HALF * gn.lda * 2; hstepBn = (size_t)HALF * gn.K * 2;
#pragma unroll
            for (int i = 0; i < 2; ++i) { voffAn[i] = (unsigned)(sR[i] * gn.lda + sC[i]) * 2u; voffBn[i] = (unsigned)(sRb[i] * gn.K + sC[i]) * 2u; }
            nA = (const char*)gn.A + (size_t)nxt.pm * 2 * hstepAn; nB = (const char*)gn.Bt + (size_t)nxt.pn * 2 * hstepBn; }
        else { hstepAn = hstepA; hstepBn = hstepB;
#pragma unroll
            for (int i = 0; i < 2; ++i) { voffAn[i] = voffA[i]; voffBn[i] = voffB[i]; } }
        for (int t = 0; t < nt; t += 2) {
            const bool last = (t == nt - 2);
            const char* a1 = cA + (size_t)(t + 1) * kstep;
            const char* a2 = last ? nA : cA + (size_t)(t + 2) * kstep; const char* b2 = last ? nB : cB + (size_t)(t + 2) * kstep;
            const char* a3 = a2 + kstep; const char* b3 = b2 + kstep;
            const unsigned vA2[2] = {last ? voffAn[0] : voffA[0], last ? voffAn[1] : voffA[1]}, vB2[2] = {last ? voffBn[0] : voffB[0], last ? voffBn[1] : voffB[1]};
            const size_t hA2 = last ? hstepAn : hstepA, hB2 = last ? hstepBn : hstepB;
            PG8_LDB(B0, 0, 0); PG8_LDB(B1, 0, 1); PG8_SCHED; PG8_LDA(At, 0, 0); PG8_STAGE(PG8_SA(1, 1), a1 + hstepA, voffA);
            PG8_WAIT_V(8); PG8_WAIT_L(0); PG8_BAR; PG8_MMA(0, 0, At, B0); PG8_MMA(0, 1, At, B1); PG8_BAR; PG8_SCHED;
            PG8_LDA(At, 0, 1); PG8_STAGE(PG8_SB(0, 0), b2, vB2); PG8_STAGE(PG8_SB(0, 1), b2 + hB2, vB2); PG8_STAGE(PG8_SA(0, 0), a2, vA2);
            PG8_WAIT_V(8); PG8_WAIT_L(0); PG8_BAR; PG8_MMA(1, 0, At, B0); PG8_MMA(1, 1, At, B1); PG8_BAR; PG8_SCHED;
            PG8_LDB(B0, 1, 0); PG8_LDB(B1, 1, 1); PG8_SCHED; PG8_LDA(At, 1, 0); PG8_STAGE(PG8_SA(0, 1), a2 + hA2, vA2);
            PG8_WAIT_V(8); PG8_WAIT_L(0); PG8_BAR; PG8_MMA(0, 0, At, B0); PG8_MMA(0, 1, At, B1); PG8_BAR; PG8_SCHED;
            PG8_LDA(At, 1, 1); PG8_STAGE(PG8_SB(1, 0), b3, vB2); PG8_STAGE(PG8_SB(1, 1), b3 + hB2, vB2); PG8_STAGE(PG8_SA(1, 0), a3, vA2);
            PG8_WAIT_V(8); PG8_WAIT_L(0); PG8_BAR; PG8_MMA(1, 0, At, B0); PG8_MMA(1, 1, At, B1); PG8_BAR; PG8_SCHED;
        }
        E(acc, cur, wr, wc, fr, fq);
        if (!has_next) break;
#pragma unroll
        for (int a = 0; a < 2; ++a)
#pragma unroll
            for (int b = 0; b < 2; ++b)
#pragma unroll
                for (int m = 0; m < 4; ++m)
#pragma unroll
                    for (int n = 0; n < 2; ++n) acc[a][b][m][n] = (f32x4){0.f, 0.f, 0.f, 0.f};
        cur = nxt; gc = gn; cA = nA; cB = nB; hstepA = hstepAn; hstepB = hstepBn; nt = gc.K / BK; ++ui;
#pragma unroll
        for (int i = 0; i < 2; ++i) { voffA[i] = voffAn[i]; voffB[i] = voffBn[i]; }
    }
    PG8_WAIT_V(0);
    if (wr == 0) PG8_BAR;
    PG8_BAR;
#undef PG8_SA
#undef PG8_SB
#undef PG8_STAGE
#undef PG8_LDA
#undef PG8_LDB
#undef PG8_MMA
#undef PG8_WAIT_V
#undef PG8_WAIT_L
#undef PG8_BAR
#undef PG8_SCHED
}
}

#ifndef PG8_SP2
#define PG8_SP2 true
#endif
#include <hip/hip_bf16.h>
#include <cmath>
namespace attn_body {
using bf16=__hip_bfloat16;
using bf16x8=__attribute__((ext_vector_type(8)))short;
using s16x4=__attribute__((ext_vector_type(4)))short;
using f32x16=__attribute__((ext_vector_type(16)))float;
using u32x4=__attribute__((ext_vector_type(4)))unsigned;
constexpr int D=64,DM=4096;
constexpr int NW=8,QBLK=32,QB=QBLK*NW,KVBLK=64;
__device__ __forceinline__ int crow(int r,int hi){return (r&3)+8*(r>>2)+4*hi;}
#define SBAR() __builtin_amdgcn_sched_barrier(0)
__device__ __forceinline__ void cmask(f32x16&p0,f32x16&p1,int jb,int qrel,int hi){
  const float NEG=-INFINITY; int kb=64*jb+4*hi;
  #pragma unroll
  for(int r=0;r<16;++r){int kv=kb+(r&3)+8*(r>>2); if(kv>qrel)p0[r]=NEG; if(kv+32>qrel)p1[r]=NEG;}
}

constexpr int NSLOT=3, SLOTB=8192;
constexpr int LDS_K=0, LDS_V=NSLOT*SLOTB, LDS_WS=3*NSLOT*SLOTB, LDS_OST=LDS_WS+NW*64*4, LDS_BYTES=LDS_OST+NW*4096;
constexpr float C2=0.125f*1.4426950408889634f;
__device__ __forceinline__ void glds16(const void*gsrc,unsigned lds_dst){unsigned keep;
  asm volatile("s_mov_b32 %0, m0\n\ts_mov_b32 m0, %2\n\ts_nop 0\n\tglobal_load_lds_dwordx4 %1, off\n\ts_mov_b32 m0, %0":"=&s"(keep):"v"(gsrc),"s"(lds_dst):"memory");}
__device__ __forceinline__ float max3f(float a,float b,float c){float r;asm("v_max3_f32 %0, %1, %2, %3":"=v"(r):"v"(a),"v"(b),"v"(c));return r;}
__device__ __forceinline__ float max2f(float a,float b){float r;asm("v_max_f32_e32 %0, %1, %2":"=v"(r):"v"(a),"v"(b));return r;}
__device__ __forceinline__ float fadd_s(float a,float b){float r;asm("v_add_f32_e32 %0, %1, %2":"=v"(r):"v"(a),"v"(b));return r;}
__device__ __forceinline__ float fsub_s(float a,float b){float r;asm("v_sub_f32_e32 %0, %1, %2":"=v"(r):"v"(a),"v"(b));return r;}
typedef float f32x2_t __attribute__((ext_vector_type(2))); typedef __bf16 bf16x2_t __attribute__((ext_vector_type(2)));
__device__ __forceinline__ unsigned cvtpk_s(float lo,float hi){f32x2_t v={lo,hi};bf16x2_t b=__builtin_convertvector(v,bf16x2_t);return __builtin_bit_cast(unsigned,b);}
#define WAIT_BAR(N) asm volatile("s_waitcnt vmcnt(" #N ") lgkmcnt(0)\n\ts_barrier":::"memory")

__device__ __forceinline__ void qkt(f32x16&p0,f32x16&p1,const char*Kslot,const bf16x8*qr,const f32x16&negm,int r32,int hi){
  const char*kb=Kslot+hi*1024+r32*16;
  #pragma unroll
  for(int d0=0;d0<4;++d0){
    const bf16x8 b0=*reinterpret_cast<const bf16x8*>(kb+d0*2048);
    const bf16x8 b1=*reinterpret_cast<const bf16x8*>(kb+d0*2048+512);
    if(d0==0){p0=__builtin_amdgcn_mfma_f32_32x32x16_bf16(b0,qr[0],negm,0,0,0);p1=__builtin_amdgcn_mfma_f32_32x32x16_bf16(b1,qr[0],negm,0,0,0);}
    else{p0=__builtin_amdgcn_mfma_f32_32x32x16_bf16(b0,qr[d0],p0,0,0,0);p1=__builtin_amdgcn_mfma_f32_32x32x16_bf16(b1,qr[d0],p1,0,0,0);}}
}
typedef __attribute__((address_space(3))) const char* lds_cptr;
typedef short v4i16_t __attribute__((ext_vector_type(4)));
__device__ __forceinline__ void kload8(bf16x8*kf,lds_cptr kp){
  kf[0]=*(const __attribute__((address_space(3))) bf16x8*)(kp);      kf[1]=*(const __attribute__((address_space(3))) bf16x8*)(kp+512);
  kf[2]=*(const __attribute__((address_space(3))) bf16x8*)(kp+2048); kf[3]=*(const __attribute__((address_space(3))) bf16x8*)(kp+2560);
  kf[4]=*(const __attribute__((address_space(3))) bf16x8*)(kp+4096); kf[5]=*(const __attribute__((address_space(3))) bf16x8*)(kp+4608);
  kf[6]=*(const __attribute__((address_space(3))) bf16x8*)(kp+6144); kf[7]=*(const __attribute__((address_space(3))) bf16x8*)(kp+6656);
}
__device__ __forceinline__ void kload2(bf16x8*kf,lds_cptr kp,int j){ kf[2*j]=*(const __attribute__((address_space(3))) bf16x8*)(kp+j*2048); kf[2*j+1]=*(const __attribute__((address_space(3))) bf16x8*)(kp+j*2048+512); }
__device__ __forceinline__ s16x4 vtr(lds_cptr p){ return __builtin_bit_cast(s16x4,__builtin_amdgcn_ds_read_tr16_b64_v4i16((__attribute__((address_space(3))) v4i16_t*)p)); }
__device__ __forceinline__ float rowmax(const f32x16&p0,const f32x16&p1){
  float a=max3f(p0[0],p0[1],p1[0]),b=max3f(p0[2],p0[3],p1[1]);a=max3f(a,p1[2],p1[3]);
  #pragma unroll
  for(int r=4;r<16;r+=4){a=max3f(a,p0[r],p0[r+1]);b=max3f(b,p0[r+2],p0[r+3]);a=max3f(a,p1[r],p1[r+1]);b=max3f(b,p1[r+2],p1[r+3]);}
  const float m=max2f(a,b);
  auto rr=__builtin_amdgcn_permlane32_swap(__float_as_uint(m),__float_as_uint(m),false,false);
  return max2f(__uint_as_float(rr[0]),__uint_as_float(rr[1]));
}
__device__ __forceinline__ void pv(f32x16*o,int vb,bf16x8 pa0,bf16x8 pa1,bf16x8 pa2,bf16x8 pa3){
  #pragma unroll
  for(int d0=0;d0<2;++d0){s16x4 lo[4],hi[4];
    #pragma unroll
    for(int ks=0;ks<4;++ks){
      asm volatile("ds_read_b64_tr_b16 %0,%1 offset:%c2":"=&v"(lo[ks]):"v"(vb),"i"(d0*4096+ks*1024):"memory");
      asm volatile("ds_read_b64_tr_b16 %0,%1 offset:%c2":"=&v"(hi[ks]):"v"(vb),"i"(d0*4096+ks*1024+512):"memory");}
    asm volatile("s_waitcnt lgkmcnt(0)":::"memory");SBAR();
    #define PK(k) (bf16x8){lo[k][0],lo[k][1],lo[k][2],lo[k][3],hi[k][0],hi[k][1],hi[k][2],hi[k][3]}
    o[d0]=__builtin_amdgcn_mfma_f32_32x32x16_bf16(pa0,PK(0),o[d0],0,0,0);
    o[d0]=__builtin_amdgcn_mfma_f32_32x32x16_bf16(pa1,PK(1),o[d0],0,0,0);
    o[d0]=__builtin_amdgcn_mfma_f32_32x32x16_bf16(pa2,PK(2),o[d0],0,0,0);
    o[d0]=__builtin_amdgcn_mfma_f32_32x32x16_bf16(pa3,PK(3),o[d0],0,0,0);
    #undef PK
  }
}

#ifndef ATTN_STORE16
#define ATTN_STORE16(p,v) (*(u32x4*)(p)=(v))
#endif
template<int THRL,int VH> __device__ __forceinline__ void attn_unit(const int MODE,const bf16*Qp,const bf16*__restrict__ Kp,const bf16*__restrict__ Vp,bf16*Op,const int opitch,const int NT,const float lam,char*shm){
  const int tid=otid(),lane=tid&63,r32=lane&31,hi=lane>>5; const int wid=__builtin_amdgcn_readfirstlane(tid>>6);
  const bf16*Qw=Qp+(long)(wid*QBLK)*DM;
  const bf16*Kh=Kp,*Vh=Vp;
  const unsigned lds0=(unsigned)(uintptr_t)shm;
  float*wsf=(float*)(shm+LDS_WS)+wid*64;
  const bf16*ksrc=Kh+(long)lane*DM+wid*8;
  const bf16*vsrc=Vh+(long)(16*(wid&3)+(lane>>2))*DM+(wid>>2)*32+(lane&3)*8;
  const unsigned kdst=lds0+LDS_K+wid*1024, vdst=lds0+LDS_V+wid*1024;
  #define DMA_K(t,slot) glds16(ksrc+(long)(t)*KVBLK*DM,(unsigned)__builtin_amdgcn_readfirstlane(kdst+(slot)))
  #define DMA_V(t,slot) do{ glds16(vsrc+(long)(t)*KVBLK*DM,(unsigned)__builtin_amdgcn_readfirstlane(vdst+2*(slot))); if(VH==2) glds16(vsrc+(long)(t)*KVBLK*DM+64,(unsigned)__builtin_amdgcn_readfirstlane(vdst+2*(slot)+8192)); }while(0)
  #define WAITB(N1,N2) do{ if(VH==2){WAIT_BAR(N2);}else{WAIT_BAR(N1);} }while(0)
  const int vb0=(int)(lds0+LDS_V)+((lane>>4)&1)*32+(lane&3)*8+(4*hi+((lane&15)>>2))*64;
  const char*Kbase=shm+LDS_K; bf16x8 kf[8];
  const lds_cptr shm3=(lds_cptr)shm; const lds_cptr kp0=shm3+LDS_K+hi*1024+r32*16; const lds_cptr vp0=shm3+LDS_V+((lane>>4)&1)*32+(lane&3)*8+(4*hi+((lane&15)>>2))*64;
  DMA_K(0,0);DMA_V(0,0);DMA_K(1,SLOTB);
  bf16x8 qr[4];
  #pragma unroll
  for(int d0=0;d0<4;++d0)qr[d0]=*reinterpret_cast<const bf16x8*>(&Qw[(long)r32*DM+d0*16+hi*8]);
  float mhat=0.f,l_reg=0.f;f32x16 o[2*VH]; _Pragma("unroll") for(int d_=0;d_<2*VH;++d_)o[d_]=f32x16{};f32x16 negm=f32x16{}; if(VH==1) asm volatile("":"+v"(negm)); const f32x16 zero16_=f32x16{};
  #define CMASK(P0,P1,t) do{}while(0)
  bool resc=false;
  #define START(P0,P1) do{ const float rm=rowmax(P0,P1); resc=false; \
    { const float dl=(VH==2)?((rm>(float)THRL)?rm:0.f):rm;   mhat=fadd_s(mhat,dl); \
      _Pragma("unroll") for(int r=0;r<16;++r){P0[r]=fsub_s(P0[r],dl);P1[r]=fsub_s(P1[r],dl);} \
      if(VH==1){ _Pragma("unroll") for(int r=0;r<16;++r)negm[r]=-mhat; asm volatile("":"+v"(negm)); } } \
    _Pragma("unroll") for(int r=0;r<16;++r)P0[r]=__builtin_amdgcn_exp2f(P0[r]); }while(0)
  #define RESC() do{ if(resc){ asm volatile("s_waitcnt lgkmcnt(0)":::"memory"); \
      _Pragma("unroll") for(int d_=0;d_<2*VH;++d_) _Pragma("unroll") for(int r=0;r<16;++r)o[d_][r]*=wsf[crow(r,hi)]; } }while(0)
  f32x16 pA0,pA1,pB0,pB1;
  int sl_prev=0,sl_cur=0,sl_next=SLOTB;
  #define ROT() do{sl_prev=sl_cur;sl_cur=sl_next;sl_next=(sl_next==(NSLOT-1)*SLOTB)?0:sl_next+SLOTB;}while(0)
  DMA_K(2,2*SLOTB);
  WAITB(3,4);
  qkt(pA0,pA1,Kbase,qr,negm,r32,hi);asm volatile("s_nop 15\n\ts_nop 7":"+v"(pA0),"+v"(pA1));CMASK(pA0,pA1,0);
  START(pA0,pA1);
  _Pragma("unroll") for(int r=0;r<16;++r)pA1[r]=__builtin_amdgcn_exp2f(pA1[r]);
  WAIT_BAR(0);
  DMA_K(3,0);DMA_V(1,SLOTB);
  ROT();
  kload8(kf,kp0+sl_cur);
  WAITB(2,3);
  s16x4 vlo[8],vhi[8]; u32x4 pw0,pw1,pw2,pw3;
  #define PKW(P,B) cvtpk_s(P[B],P[B+1])
  #define PAF(k) __builtin_bit_cast(bf16x8,pw##k)
  #define VFR(i) (bf16x8){vlo[i][0],vlo[i][1],vlo[i][2],vlo[i][3],vhi[i][0],vhi[i][1],vhi[i][2],vhi[i][3]}
  #define PIN(x) asm volatile("":"+v"(x))
  #define MX3(a,b,c) __builtin_fmaxf(__builtin_fmaxf((a),(b)),(c))
  #define GAPA(MF,A0,A1,A2,A3,W0,W1,PW) do{ MF; sacc+=A0; sacc+=A1; sacc+=A2; sacc+=A3; PIN(sacc); W0; W1; PIN(PW); SBAR(); }while(0)
  #define EX(v) __builtin_amdgcn_exp2f(v)
  #define GAPB(MF,X,B) do{ MF; X[B]=EX(X[B]); X[B+1]=EX(X[B+1]); X[B+2]=EX(X[B+2]); X[B+3]=EX(X[B+3]); PIN(X); SBAR(); }while(0)
  #define GAPB2(MF,X,B) do{ MF; X[B]=EX(X[B]); X[B+1]=EX(X[B+1]); PIN(X); SBAR(); }while(0)
  #define VRD(i) do{ vlo[i]=vtr(vp_+(((i)>>2)*4096+((i)&3)*1024)); vhi[i]=vtr(vp_+(((i)>>2)*4096+((i)&3)*1024+512)); }while(0)
  #define KRD(G,j) do{ if(G){ kload2(kf,kp0+sl_next,j); SBAR(); } }while(0)
  #define V2RD(i) do{ if(VH==2){ vlo[i]=vtr(vp_+8192+(((i)>>2)*4096+((i)&3)*1024)); vhi[i]=vtr(vp_+8192+(((i)>>2)*4096+((i)&3)*1024+512)); SBAR(); } }while(0)
  #define STEP(C0,C1,P0,P1,t,GK,GV,GL) do{ SBAR(); \
    const lds_cptr vp_=vp0+2*sl_prev; \
    VRD(0); SBAR(); float sacc=(P0[0]+P0[1]); \
    GAPA(C0=__builtin_amdgcn_mfma_f32_32x32x16_bf16(kf[0],qr[0],(VH==1?negm:zero16_),0,0,0), P0[2],P0[3],P0[4],P0[5],     pw0[0]=PKW(P0,0), pw0[1]=PKW(P0,2), pw0); \
    VRD(4); SBAR(); GAPA(C1=__builtin_amdgcn_mfma_f32_32x32x16_bf16(kf[1],qr[0],(VH==1?negm:zero16_),0,0,0), P0[6],P0[7],P0[8],P0[9],     pw0[2]=PKW(P0,4), pw0[3]=PKW(P0,6), pw0); \
    VRD(1); SBAR(); GAPA(C0=__builtin_amdgcn_mfma_f32_32x32x16_bf16(kf[2],qr[1],C0,0,0,0),   P0[10],P0[11],P0[12],P0[13], pw1[0]=PKW(P0,8), pw1[1]=PKW(P0,10), pw1); \
    VRD(5); SBAR(); GAPA(C1=__builtin_amdgcn_mfma_f32_32x32x16_bf16(kf[3],qr[1],C1,0,0,0),   P0[14],P0[15],P1[0],P1[1],   pw1[2]=PKW(P0,12),pw1[3]=PKW(P0,14), pw1); \
    VRD(2); SBAR(); GAPA(C0=__builtin_amdgcn_mfma_f32_32x32x16_bf16(kf[4],qr[2],C0,0,0,0),   P1[2],P1[3],P1[4],P1[5],     pw2[0]=PKW(P1,0), pw2[1]=PKW(P1,2), pw2); \
    VRD(6); SBAR(); GAPA(C1=__builtin_amdgcn_mfma_f32_32x32x16_bf16(kf[5],qr[2],C1,0,0,0),   P1[6],P1[7],P1[8],P1[9],     pw2[2]=PKW(P1,4), pw2[3]=PKW(P1,6), pw2); \
    VRD(3); SBAR(); GAPA(C0=__builtin_amdgcn_mfma_f32_32x32x16_bf16(kf[6],qr[3],C0,0,0,0),   P1[10],P1[11],P1[12],P1[13], pw3[0]=PKW(P1,8), pw3[1]=PKW(P1,10), pw3); \
    VRD(7); SBAR(); GAPA(C1=__builtin_amdgcn_mfma_f32_32x32x16_bf16(kf[7],qr[3],C1,0,0,0),   P1[14],P1[15],0.f,0.f,       pw3[2]=PKW(P1,12),pw3[3]=PKW(P1,14), pw3); \
    l_reg+=sacc; \
    if(GK){DMA_K((t)+3,sl_cur);} if(GV){DMA_V((t)+1,sl_next);} \
    CMASK(C0,C1,t); \
    if(VH==2){ if(__builtin_expect(__any(mhat!=0.f),0)){ _Pragma("unroll") for(int r=0;r<16;++r){C0[r]-=mhat;C1[r]-=mhat;} } } \
    { float a=MX3(C0[0],C0[1],C1[0]),b=MX3(C0[2],C0[3],C1[1]); a=MX3(a,C1[2],C1[3]); \
      _Pragma("unroll") for(int r=4;r<16;r+=4){a=MX3(a,C0[r],C0[r+1]);b=MX3(b,C0[r+2],C0[r+3]);a=MX3(a,C1[r],C1[r+1]);b=MX3(b,C1[r+2],C1[r+3]);} \
      float rm=__builtin_fmaxf(a,b); { auto rr=__builtin_amdgcn_permlane32_swap(__float_as_uint(rm),__float_as_uint(rm),false,false); rm=__builtin_fmaxf(__uint_as_float(rr[0]),__uint_as_float(rr[1])); } \
      resc=false; \
      if(__builtin_expect(__any(rm>(float)THRL),0)){ const float dl=__builtin_fmaxf(rm,0.f); mhat+=dl; \
        _Pragma("unroll") for(int r=0;r<16;++r){C0[r]-=dl;C1[r]-=dl;} \
        if(VH==1){ _Pragma("unroll") for(int r=0;r<16;++r)negm[r]=-mhat; asm volatile("":"+v"(negm)); } \
        const float f=__builtin_amdgcn_exp2f(-dl); l_reg*=f; if(hi==0)wsf[r32]=f; resc=true; } } \
    SBAR(); \
    if(VH==1){ \
    GAPB(o[0]=__builtin_amdgcn_mfma_f32_32x32x16_bf16(PAF(0),VFR(0),o[0],0,0,0), C0,0); \
    GAPB(o[1]=__builtin_amdgcn_mfma_f32_32x32x16_bf16(PAF(0),VFR(4),o[1],0,0,0), C0,4); \
    KRD(GL,0); GAPB(o[0]=__builtin_amdgcn_mfma_f32_32x32x16_bf16(PAF(1),VFR(1),o[0],0,0,0), C0,8); \
    KRD(GL,1); GAPB(o[1]=__builtin_amdgcn_mfma_f32_32x32x16_bf16(PAF(1),VFR(5),o[1],0,0,0), C0,12); \
    KRD(GL,2); GAPB(o[0]=__builtin_amdgcn_mfma_f32_32x32x16_bf16(PAF(2),VFR(2),o[0],0,0,0), C1,0); \
    KRD(GL,3); GAPB(o[1]=__builtin_amdgcn_mfma_f32_32x32x16_bf16(PAF(2),VFR(6),o[1],0,0,0), C1,4); \
    GAPB(o[0]=__builtin_amdgcn_mfma_f32_32x32x16_bf16(PAF(3),VFR(3),o[0],0,0,0), C1,8); \
    GAPB(o[1]=__builtin_amdgcn_mfma_f32_32x32x16_bf16(PAF(3),VFR(7),o[1],0,0,0), C1,12); \
    } else {   \
    GAPB2(o[0]=__builtin_amdgcn_mfma_f32_32x32x16_bf16(PAF(0),VFR(0),o[0],0,0,0), C0,0); V2RD(0); \
    GAPB2(o[1]=__builtin_amdgcn_mfma_f32_32x32x16_bf16(PAF(0),VFR(4),o[1],0,0,0), C0,2); V2RD(4); \
    KRD(GL,0); GAPB2(o[0]=__builtin_amdgcn_mfma_f32_32x32x16_bf16(PAF(1),VFR(1),o[0],0,0,0), C0,4); V2RD(1); \
    KRD(GL,1); GAPB2(o[1]=__builtin_amdgcn_mfma_f32_32x32x16_bf16(PAF(1),VFR(5),o[1],0,0,0), C0,6); V2RD(5); \
    KRD(GL,2); GAPB2(o[0]=__builtin_amdgcn_mfma_f32_32x32x16_bf16(PAF(2),VFR(2),o[0],0,0,0), C0,8); V2RD(2); \
    KRD(GL,3); GAPB2(o[1]=__builtin_amdgcn_mfma_f32_32x32x16_bf16(PAF(2),VFR(6),o[1],0,0,0), C0,10); V2RD(6); \
    GAPB2(o[0]=__builtin_amdgcn_mfma_f32_32x32x16_bf16(PAF(3),VFR(3),o[0],0,0,0), C0,12); V2RD(3); \
    GAPB2(o[1]=__builtin_amdgcn_mfma_f32_32x32x16_bf16(PAF(3),VFR(7),o[1],0,0,0), C0,14); V2RD(7); \
    GAPB2(o[2*VH-2]=__builtin_amdgcn_mfma_f32_32x32x16_bf16(PAF(0),VFR(0),o[2*VH-2],0,0,0), C1,0); \
    GAPB2(o[2*VH-1]=__builtin_amdgcn_mfma_f32_32x32x16_bf16(PAF(0),VFR(4),o[2*VH-1],0,0,0), C1,2); \
    GAPB2(o[2*VH-2]=__builtin_amdgcn_mfma_f32_32x32x16_bf16(PAF(1),VFR(1),o[2*VH-2],0,0,0), C1,4); \
    GAPB2(o[2*VH-1]=__builtin_amdgcn_mfma_f32_32x32x16_bf16(PAF(1),VFR(5),o[2*VH-1],0,0,0), C1,6); \
    GAPB2(o[2*VH-2]=__builtin_amdgcn_mfma_f32_32x32x16_bf16(PAF(2),VFR(2),o[2*VH-2],0,0,0), C1,8); \
    GAPB2(o[2*VH-1]=__builtin_amdgcn_mfma_f32_32x32x16_bf16(PAF(2),VFR(6),o[2*VH-1],0,0,0), C1,10); \
    GAPB2(o[2*VH-2]=__builtin_amdgcn_mfma_f32_32x32x16_bf16(PAF(3),VFR(3),o[2*VH-2],0,0,0), C1,12); \
    GAPB2(o[2*VH-1]=__builtin_amdgcn_mfma_f32_32x32x16_bf16(PAF(3),VFR(7),o[2*VH-1],0,0,0), C1,14); \
    } \
    }while(0)
  int t=1;
  #undef CMASK
  #define CMASK(P0,P1,t) do{}while(0)
  for(;t+5<NT;t+=2){
    STEP(pB0,pB1,pA0,pA1,t,true,true,true);     WAITB(2,3); RESC(); ROT();
    STEP(pA0,pA1,pB0,pB1,t+1,true,true,true);   WAITB(2,3); RESC(); ROT();
  }
  #undef CMASK
  #define CMASK(P0,P1,t) do{}while(0)
  #define ENDW(tt) do{ if((tt)+3<NT){WAITB(2,3);} else if((tt)+2<NT){WAITB(1,2);} else {WAIT_BAR(0);} }while(0)
  for(;t+1<NT;t+=2){
    STEP(pB0,pB1,pA0,pA1,t,(t+3<NT),(t+1<NT),(t+1<NT));       ENDW(t);   RESC(); ROT();
    STEP(pA0,pA1,pB0,pB1,t+1,(t+4<NT),(t+2<NT),(t+2<NT));     ENDW(t+1); RESC(); ROT();
  }
  STEP(pB0,pB1,pA0,pA1,NT-1,false,false,false); RESC();
  { float sacc=pB0[0]+pB0[1]; _Pragma("unroll") for(int r=2;r<16;++r)sacc+=pB0[r]; _Pragma("unroll") for(int r=0;r<16;++r)sacc+=pB1[r]; l_reg+=sacc;
    pw0=(u32x4){PKW(pB0,0),PKW(pB0,2),PKW(pB0,4),PKW(pB0,6)};pw1=(u32x4){PKW(pB0,8),PKW(pB0,10),PKW(pB0,12),PKW(pB0,14)};pw2=(u32x4){PKW(pB1,0),PKW(pB1,2),PKW(pB1,4),PKW(pB1,6)};pw3=(u32x4){PKW(pB1,8),PKW(pB1,10),PKW(pB1,12),PKW(pB1,14)};
    SBAR(); pv(o,vb0+2*sl_cur,PAF(0),PAF(1),PAF(2),PAF(3)); if(VH==2) pv(o+2,vb0+2*sl_cur+8192,PAF(0),PAF(1),PAF(2),PAF(3)); }
  #undef PKW
  #undef PAF
  #undef VFR
  #undef PIN
  #undef MX3
  #undef GAPA
  #undef GAPB
  #undef GAPB2
  #undef EX
  #undef VRD
  #undef KRD
  #undef V2RD
  #undef STEP
  #undef ENDW
  {auto rr=__builtin_amdgcn_permlane32_swap(__float_as_uint(l_reg),__float_as_uint(l_reg),false,false);l_reg=__uint_as_float(rr[0])+__uint_as_float(rr[1]);}
  if(hi==0)wsf[32+r32]=l_reg;asm volatile("s_waitcnt lgkmcnt(0)":::"memory");
  float rli[16];
  #pragma unroll
  for(int r=0;r<16;++r)rli[r]=__builtin_amdgcn_rcpf(wsf[32+crow(r,hi)]);
  bf16*Ow=Op+(long)(wid*QBLK)*opitch;
  { bf16*stg=(bf16*)(shm+LDS_OST)+wid*2048;
    #pragma unroll
    for(int hf=0;hf<VH;++hf){
    #pragma unroll
    for(int r=0;r<16;++r){const int orow=crow(r,hi);
      #pragma unroll
      for(int d0=0;d0<2;++d0)stg[orow*64+d0*32+r32]=__float2bfloat16(o[hf*2+d0][r]*rli[r]);}
    asm volatile("s_waitcnt lgkmcnt(0)":::"memory");
    #pragma unroll
    for(int i=0;i<4;++i){const int row=i*8+(lane>>3),ch=lane&7; u32x4 v=*(const u32x4*)(stg+row*64+ch*8); bf16*dst=Ow+(long)row*opitch+hf*64+ch*8;
      if(MODE==2){ const u32x4 old=*(const u32x4*)dst;
        #pragma unroll
        for(int e=0;e<4;++e){ const float a0=__uint_as_float(old[e]<<16)-lam*__uint_as_float(v[e]<<16), a1=__uint_as_float(old[e]&0xffff0000u)-lam*__uint_as_float(v[e]&0xffff0000u); v[e]=cvtpk_s(a0,a1); } }
      ATTN_STORE16(dst,v);}
    asm volatile("s_waitcnt lgkmcnt(0)":::"memory");
    } }
  asm volatile("s_waitcnt lgkmcnt(0)\n\ts_barrier":::"memory");
  #undef DMA_K
  #undef DMA_V
  #undef WAITB
  #undef CMASK
  #undef START
  #undef RESC
  #undef ROT
}
constexpr int ATTN_LDS_BYTES=LDS_BYTES;
#undef SBAR
#undef WAIT_BAR
}

typedef unsigned short bf16;
typedef unsigned v4u __attribute__((ext_vector_type(4)));
typedef unsigned v2u __attribute__((ext_vector_type(2)));
typedef float f32x4 __attribute__((ext_vector_type(4)));
typedef float f32x2 __attribute__((ext_vector_type(2)));
typedef short bf16x8 __attribute__((ext_vector_type(8)));

constexpr int NB = 4, SEQ = 8192, CTXL = 256, TPB = SEQ + CTXL, MALL = NB * TPB, DMOD = 1024;
constexpr int NCH = TPB / 128;
constexpr int PW = 4096;
constexpr int PC_Z = 0, PC_XBC = 512, PC_DT = 1280, PC_DQ = 1296, PC_DK = 1808, PC_DV = 2320, PC_GQ = 2832, PC_GK = 3344, PC_GV = 3472, PC_U = 3600;
constexpr int PC_YD = 512, PC_XM = 1296;
constexpr int FFH = 2816;
constexpr float EPS = 1e-6f;
constexpr float QSCALE = 0.125f * 1.4426950408889634f;
constexpr int NTHR = 512;

constexpr size_t KiB = 1024, MiB = 1024 * 1024;
constexpr size_t WS_MOD = 0;
constexpr size_t WS_LAM = 250 * KiB;
constexpr size_t WS_QCTR = 252 * KiB;
constexpr size_t WS_BAR = 254 * KiB;
constexpr size_t WS_DEC = 256 * KiB;
constexpr size_t WS_HC = 512 * KiB;
constexpr size_t WS_WT = 4 * MiB + 512 * KiB;
constexpr size_t WT_IN = 0, WT_G = WT_IN + (size_t)4096 * 1024 * 2, WT_BR = WT_G + (size_t)4096 * 1024 * 2, WT_O = WT_BR + (size_t)1024 * 1920 * 2,
                 WT_GU = WT_O + (size_t)1024 * 1024 * 2, WT_DN = WT_GU + (size_t)5632 * 1024 * 2, WT_GLU = WT_DN + (size_t)1024 * 2816 * 2, WT_END = WT_GLU + (size_t)768 * 384 * 2;
constexpr size_t WS_XN = 43 * MiB + 512 * KiB;
constexpr size_t WS_P = WS_XN + 66 * MiB;
constexpr size_t WS_YB = WS_P + 264 * MiB;
constexpr size_t WS_ARENA = WS_YB + 33 * MiB;
constexpr size_t WS_XBC = WS_ARENA;
constexpr size_t WS_SST = WS_XBC + 49 * MiB + 512 * KiB;
constexpr size_t WS_DT = WS_SST + 33 * MiB;
constexpr size_t WS_S5 = WS_DT + 2 * MiB + 256 * KiB;
constexpr size_t WS_MS = WS_ARENA;
constexpr size_t WS_GS = WS_ARENA + 64 * MiB;
constexpr size_t WS_SSQ = 503 * MiB;
constexpr size_t WS_XBAR = 506 * MiB;
constexpr size_t WS_NEED = 512 * MiB;
static_assert(WT_END <= 39 * MiB, "wt");
static_assert(WS_S5 + 7 * MiB <= WS_SSQ && WS_GS + 32 * MiB <= WS_SSQ && WS_SSQ + MiB <= WS_NEED && (size_t)MALL * PW * 2 <= 264 * MiB, "ws map");

constexpr int LDS_TOTAL = 152 * 1024;

struct Args { const float* in[42]; float* out; unsigned char* ws; int ph_lo, ph_hi; };

__device__ __forceinline__ size_t ozero() { size_t z = 0; asm volatile("" : "+s"(z)); return z; }
__device__ __forceinline__ const float* oin(const Args& A, int i) { return A.in[i] + ozero(); }
__device__ __forceinline__ unsigned char* ows(const Args& A) { return A.ws + ozero(); }
__device__ __forceinline__ float* oout(const Args& A) { return A.out + ozero(); }
__device__ __forceinline__ int obid() { int b = __builtin_amdgcn_readfirstlane((int)blockIdx.x); asm volatile("" : "+s"(b)); return b; }
__device__ __forceinline__ int ogrid() { int b = __builtin_amdgcn_readfirstlane((int)gridDim.x); asm volatile("" : "+s"(b)); return b; }
typedef __bf16 hwbf16x2_t __attribute__((ext_vector_type(2)));
__device__ __forceinline__ unsigned pk2(float lo, float hi) { const f32x2 v = {lo, hi}; return __builtin_bit_cast(unsigned, __builtin_convertvector(v, hwbf16x2_t)); }
__device__ __forceinline__ unsigned f2bf(float f) { return pk2(f, 0.f) & 0xffffu; }
__device__ __forceinline__ float bf2f(unsigned short h) { return __builtin_bit_cast(float, (unsigned)h << 16); }
__device__ __forceinline__ float bflo(unsigned v) { return __builtin_bit_cast(float, v << 16); }
__device__ __forceinline__ float bfhi(unsigned v) { return __builtin_bit_cast(float, v & 0xffff0000u); }
__device__ __forceinline__ float wave_sum(float v) {
    v += __builtin_bit_cast(float, __builtin_amdgcn_update_dpp(0, __builtin_bit_cast(int, v), 0xB1, 0xF, 0xF, true));
    v += __builtin_bit_cast(float, __builtin_amdgcn_update_dpp(0, __builtin_bit_cast(int, v), 0x4E, 0xF, 0xF, true));
    v += __builtin_bit_cast(float, __builtin_amdgcn_update_dpp(0, __builtin_bit_cast(int, v), 0x141, 0xF, 0xF, true));
    v += __builtin_bit_cast(float, __builtin_amdgcn_update_dpp(0, __builtin_bit_cast(int, v), 0x140, 0xF, 0xF, true));
    v += __shfl_xor(v, 16); v += __shfl_xor(v, 32);
    return v;
}
__device__ __forceinline__ float sigmoidf_(float x) { return __builtin_amdgcn_rcpf(1.f + __expf(-x)); }
__device__ __forceinline__ float siluf_(float x) { return x * __builtin_amdgcn_rcpf(1.f + __expf(-x)); }
#define LDSW() asm volatile("s_waitcnt lgkmcnt(0)" ::: "memory")
#define XB_TMO      128
#define XB_XCNT(j)  (256  + 64 * (j))
#define XB_XSUB(j)  (1280 + 64 * (j))
#define XB_XGEN(j)  (2304 + 64 * (j))
#define XB_TOP      3328
#define XB_TOPGEN   3392
#define XCD_BAR_WORDS 3456
#define XB_SPIN_CAP (1u << 18)

__device__ __forceinline__ unsigned xb_ld(unsigned* p)              { return __hip_atomic_load(p, __ATOMIC_RELAXED, __HIP_MEMORY_SCOPE_AGENT); }
__device__ __forceinline__ unsigned xb_add(unsigned* p, unsigned v) { return __hip_atomic_fetch_add(p, v, __ATOMIC_RELAXED, __HIP_MEMORY_SCOPE_AGENT); }
__device__ __forceinline__ unsigned xb_xcc_id() { return (unsigned)__builtin_amdgcn_s_getreg((3 << 11) | 20) & 0xFu; }
#define XB_SPIN(cond, bar) do { unsigned _sp = 0; while (cond) { __builtin_amdgcn_s_sleep(1); \
    if ((++_sp & 255u) == 0u) { if (xb_ld(&(bar)[XB_TMO])) break; if (_sp > XB_SPIN_CAP) { atomicAdd(&(bar)[XB_TMO], 1u); break; } } } } while (0)

struct XcdBarrier {
    unsigned* bar; unsigned x;
    volatile unsigned* st;
};

__device__ __forceinline__ XcdBarrier xcd_barrier_post(unsigned* bar, volatile unsigned* st) {
    XcdBarrier b; b.bar = bar; b.x = xb_xcc_id(); b.st = st;
    if (otid() == 0) (void)xb_add(&bar[XB_XCNT(b.x)], 1u);
    return b;
}
__device__ __forceinline__ void xcd_barrier_complete(unsigned* bar, unsigned x, unsigned& nloc, unsigned& nx) {
    const unsigned G = gridDim.x * gridDim.y * gridDim.z;
    unsigned sum, cnt, mine, sp = 0u;
    for (;;) {
        sum = 0u; cnt = 0u; mine = 0u;
#pragma unroll
        for (unsigned j = 0; j < 16; ++j) { const unsigned c = xb_ld(&bar[XB_XCNT(j)]); sum += c; cnt += (c > 0u) ? 1u : 0u; mine = (j == x) ? c : mine; }
        if (sum == G) break;
        __builtin_amdgcn_s_sleep(1);
        if ((++sp & 255u) == 0u) { if (xb_ld(&bar[XB_TMO])) break; if (sp > XB_SPIN_CAP) { atomicAdd(&bar[XB_TMO], 1u); break; } }
    }
    nloc = mine > 0u ? mine : 1u; nx = cnt > 0u ? cnt : 1u;
}

__device__ __forceinline__ void xcd_barrier(const XcdBarrier& b) {
    asm volatile("s_waitcnt vmcnt(0)" ::: "memory");
    __syncthreads();
    if (otid() == 0) {
        unsigned* bar = b.bar;
        __builtin_amdgcn_s_waitcnt(0);
        unsigned nloc = b.st[0], nx = b.st[1];
        if (nloc == 0u) { xcd_barrier_complete(bar, b.x, nloc, nx); b.st[0] = nloc; b.st[1] = nx; }
        const unsigned old = xb_add(&bar[XB_XSUB(b.x)], 1u);
        const unsigned gen = old / nloc;
        if (old + 1u == (gen + 1u) * nloc) {
            __builtin_amdgcn_fence(__ATOMIC_RELEASE, "agent");
            asm volatile("s_waitcnt vmcnt(0)" ::: "memory");
            const unsigned og = xb_add(&bar[XB_TOP], 1u);
            const unsigned tg = og / nx;
            if (og + 1u == (tg + 1u) * nx) xb_add(&bar[XB_TOPGEN], 1u);
            else XB_SPIN(xb_ld(&bar[XB_TOPGEN]) == tg, bar);
            __builtin_amdgcn_fence(__ATOMIC_ACQUIRE, "agent");
            xb_add(&bar[XB_XGEN(b.x)], 1u);
            asm volatile("s_waitcnt vmcnt(0)" ::: "memory");
        } else {
            XB_SPIN(xb_ld(&bar[XB_XGEN(b.x)]) == gen, bar);
            __builtin_amdgcn_fence(__ATOMIC_ACQUIRE, "agent");
            asm volatile("s_waitcnt vmcnt(0)" ::: "memory");
        }
    }
    __syncthreads();
}
constexpr int LDS_XBST_OFF = 152 * 1024 - 16 - 256 - 16;
__device__ __forceinline__ void grid_barrier(unsigned* bar) {
    XcdBarrier b; b.bar = bar; b.x = xb_xcc_id(); b.st = (volatile unsigned*)(g_lds_ + LDS_XBST_OFF);
    xcd_barrier(b);
}
struct RSched {
    pg8::StaticOrder so; int skip;
    __device__ __forceinline__ void init(int N, int G, int c, bool skipctx) { so.init((skipctx ? 128 : 132) * 256, N, G, c); skip = skipctx ? 1 : 0; }
    __device__ __forceinline__ bool next(int i, pg8::Unit& u) const { if (!so.next(i, u)) return false; if (skip) u.pm = u.pm + u.pm / 32 + 1; return true; }
    __device__ __forceinline__ void a_ready(const pg8::Unit&) const {}
    __device__ __forceinline__ void done(const pg8::Unit&) const {}
};
struct OneSched {
    pg8::Unit u;
    __device__ __forceinline__ bool next(int i, pg8::Unit& o) const { if (i != 0) return false; o = u; return true; }
    __device__ __forceinline__ void a_ready(const pg8::Unit&) const {}
    __device__ __forceinline__ void done(const pg8::Unit&) const {}
};

struct EpiStore {
    static constexpr bool PERM = true, AFTER_DRAIN = false, BIAS_INIT = false;
    bf16* O; int ldc;
    __device__ __forceinline__ void operator()(const pg8::f32x4 (&acc)[2][2][4][2], const pg8::Unit& u, int wr, int wc, int fr, int fq) const {
        const int row0 = u.pm * 256 + wr * 64 + fr, col0 = u.pn * 256 + wc * 32 + 8 * fq;
#pragma unroll
        for (int ai = 0; ai < 2; ++ai)
#pragma unroll
            for (int m = 0; m < 4; ++m) { bf16* rowp = O + (size_t)(row0 + ai * 128 + m * 16) * ldc + col0;
#pragma unroll
                for (int bj = 0; bj < 2; ++bj) { const pg8::f32x4 v0 = acc[ai][bj][m][0], v1 = acc[ai][bj][m][1];
                    v4u w; w.x = pg8::cvt_pk_bf16(v0[0], v0[1]); w.y = pg8::cvt_pk_bf16(v0[2], v0[3]); w.z = pg8::cvt_pk_bf16(v1[0], v1[1]); w.w = pg8::cvt_pk_bf16(v1[2], v1[3]);
                    *(v4u*)(rowp + bj * 128) = w; } }
    }
};
template <int ACT> struct EpiPair {
    static constexpr bool PERM = true, AFTER_DRAIN = false, BIAS_INIT = (ACT == 1);
    bf16* O; int ldc; const float* bias; int half;
    __device__ __forceinline__ void init(pg8::f32x4 (&acc)[2][2][4][2], const pg8::Unit& u, int wc, int fq) const {
        const float* bp = bias + u.pn * 128 + wc * 32 + 8 * fq;
#pragma unroll
        for (int bj = 0; bj < 2; ++bj)
#pragma unroll
            for (int n = 0; n < 2; ++n) { const pg8::f32x4 bv = *(const pg8::f32x4*)(bp + bj * half + 4 * n);
#pragma unroll
                for (int ai = 0; ai < 2; ++ai)
#pragma unroll
                    for (int m = 0; m < 4; ++m) acc[ai][bj][m][n] = bv; }
    }
    __device__ __forceinline__ void operator()(const pg8::f32x4 (&acc)[2][2][4][2], const pg8::Unit& u, int wr, int wc, int fr, int fq) const {
        const int row0 = u.pm * 256 + wr * 64 + fr, col0 = u.pn * 128 + wc * 32 + 8 * fq;
#pragma unroll
        for (int ai = 0; ai < 2; ++ai) { bf16* rowp = O + (size_t)(row0 + ai * 128) * ldc + col0; asm volatile("" : "+v"(rowp));
#pragma unroll
            for (int m = 0; m < 4; ++m) { float o[8];
#pragma unroll
                for (int n = 0; n < 2; ++n)
#pragma unroll
                    for (int j = 0; j < 4; ++j) { const float a = acc[ai][0][m][n][j], b = acc[ai][1][m][n][j];
                        o[n * 4 + j] = (ACT == 0) ? siluf_(a) * b : a * sigmoidf_(b); }
                v4u w; w.x = pg8::cvt_pk_bf16(o[0], o[1]); w.y = pg8::cvt_pk_bf16(o[2], o[3]); w.z = pg8::cvt_pk_bf16(o[4], o[5]); w.w = pg8::cvt_pk_bf16(o[6], o[7]);
                *(v4u*)rowp = w; rowp += (size_t)16 * ldc; asm volatile("" : "+v"(rowp)); } }
    }
};
struct EpiRes {
    static constexpr bool PERM = false, AFTER_DRAIN = false, BIAS_INIT = false;
    const float* base_lat; const float* base_ctx; float* out_lat; float* out_ctx; const float* mod; int goff;
    __device__ __forceinline__ void operator()(const pg8::f32x4 (&acc)[2][2][4][2], const pg8::Unit& u, int wr, int wc, int fr, int fq) const {
        const int b = u.pm / 33, kb = u.pm % 33;
        const float* bp; float* op; const float* gp;
        if (kb == 0) { bp = base_ctx + (size_t)b * CTXL * DMOD; op = out_ctx + (size_t)b * CTXL * DMOD; gp = mod + 4 * 6144 + goff; }
        else { const size_t off = ((size_t)b * SEQ + (size_t)(kb - 1) * 256) * DMOD; bp = base_lat + off; op = out_lat + off; gp = mod + b * 6144 + goff; }
        const int col0 = u.pn * 256 + wc * 32 + 4 * fq;
#pragma unroll
        for (int bj = 0; bj < 2; ++bj)
#pragma unroll
            for (int n = 0; n < 2; ++n) {
                const int col = col0 + bj * 128 + n * 16; const pg8::f32x4 gv = *(const pg8::f32x4*)(gp + col); pg8::f32x4 bs[8];
#pragma unroll
                for (int ai = 0; ai < 2; ++ai)
#pragma unroll
                    for (int m = 0; m < 4; ++m) bs[ai * 4 + m] = *(const pg8::f32x4*)(bp + (size_t)(ai * 128 + wr * 64 + m * 16 + fr) * DMOD + col);
#pragma unroll
                for (int ai = 0; ai < 2; ++ai)
#pragma unroll
                    for (int m = 0; m < 4; ++m) *(pg8::f32x4*)(op + (size_t)(ai * 128 + wr * 64 + m * 16 + fr) * DMOD + col) = bs[ai * 4 + m] + gv * acc[ai][bj][m][n];
                asm volatile("" ::: "memory"); }
    }
};
#define OPQ(p) asm volatile("" : "+v"(p))
struct EpiGate {
    static constexpr bool PERM = true, AFTER_DRAIN = false, BIAS_INIT = false;
    v4u* Gs;
    __device__ __forceinline__ void operator()(const pg8::f32x4 (&acc)[2][2][4][2], const pg8::Unit& u, int wr, int wc, int fr, int fq) const {
        v4u* gp = Gs + otid(); OPQ(gp);
#pragma unroll
        for (int ai = 0; ai < 2; ++ai)
#pragma unroll
            for (int bj = 0; bj < 2; ++bj)
#pragma unroll
                for (int m = 0; m < 4; ++m) { const pg8::f32x4 v0 = acc[ai][bj][m][0], v1 = acc[ai][bj][m][1]; v4u w;
                    w.x = pg8::cvt_pk_bf16(sigmoidf_(v0[0]), sigmoidf_(v0[1])); w.y = pg8::cvt_pk_bf16(sigmoidf_(v0[2]), sigmoidf_(v0[3]));
                    w.z = pg8::cvt_pk_bf16(sigmoidf_(v1[0]), sigmoidf_(v1[1])); w.w = pg8::cvt_pk_bf16(sigmoidf_(v1[2]), sigmoidf_(v1[3]));
                    *gp = w; gp += 512; OPQ(gp); }
    }
};
struct EpiBranch {
    static constexpr bool PERM = true, AFTER_DRAIN = false, BIAS_INIT = false;
    const v4u* Gs; v4u* Ms; bf16* XM; int ldc; int first, last; const float* ssq;
    __device__ __forceinline__ void operator()(const pg8::f32x4 (&acc)[2][2][4][2], const pg8::Unit& u, int wr, int wc, int fr, int fq) const {
        const int tid = otid(); const int row0 = u.pm * 256 + wr * 64 + fr, col0 = u.pn * 256 + wc * 32 + 8 * fq;
        const v4u* gp = Gs + tid; v4u* mp = Ms + tid; OPQ(gp); OPQ(mp);
#pragma unroll
        for (int ai = 0; ai < 2; ++ai)
#pragma unroll
            for (int bj = 0; bj < 2; ++bj) { bf16* xp = XM + (size_t)(row0 + ai * 128) * ldc + col0 + bj * 128; OPQ(xp);
                v4u gw[4], pm_[4]; float rs[4];
#pragma unroll
                for (int m = 0; m < 4; ++m) { gw[m] = gp[m * 512]; if (!first) pm_[m] = mp[m * 512]; else pm_[m] = (v4u){0u, 0u, 0u, 0u};
                    rs[m] = 1.f; if (first) { const f32x2 sq = *(const f32x2*)(ssq + (size_t)(row0 + ai * 128 + m * 16) * 2); rs[m] = rsqrtf((sq.x + sq.y) * (1.f / 512.f) + EPS); } }
#pragma unroll
                for (int m = 0; m < 4; ++m) {
                    pg8::f32x4 g0 = {bflo(gw[m].x), bfhi(gw[m].x), bflo(gw[m].y), bfhi(gw[m].y)}, g1 = {bflo(gw[m].z), bfhi(gw[m].z), bflo(gw[m].w), bfhi(gw[m].w)};
                    pg8::f32x4 m0 = g0 * acc[ai][bj][m][0] * rs[m], m1 = g1 * acc[ai][bj][m][1] * rs[m];
                    m0 += (pg8::f32x4){bflo(pm_[m].x), bfhi(pm_[m].x), bflo(pm_[m].y), bfhi(pm_[m].y)}; m1 += (pg8::f32x4){bflo(pm_[m].z), bfhi(pm_[m].z), bflo(pm_[m].w), bfhi(pm_[m].w)};
                    v4u w; w.x = pg8::cvt_pk_bf16(m0[0], m0[1]); w.y = pg8::cvt_pk_bf16(m0[2], m0[3]); w.z = pg8::cvt_pk_bf16(m1[0], m1[1]); w.w = pg8::cvt_pk_bf16(m1[2], m1[3]);
                    if (last) *(v4u*)(xp + (size_t)(m * 16) * ldc) = w; else mp[m * 512] = w; }
                gp += 2048; mp += 2048; OPQ(gp); OPQ(mp); }
    }
};
struct EpiMerge {
    static constexpr bool PERM = true, AFTER_DRAIN = false, BIAS_INIT = false;
    v4u* Gs; v4u* Ms; bf16* XM; int ldc; const float* ssq;
    __device__ __forceinline__ void operator()(const pg8::f32x4 (&acc)[2][2][4][2], const pg8::Unit& u, int wr, int wc, int fr, int fq) const {
        v4u* gt = Gs + (size_t)((u.aux >> 1) & 1) * 8192;
        if ((u.aux & 1) == 0) { EpiGate E{gt}; E(acc, u, wr, wc, fr, fq); }
        else { EpiBranch E{gt, Ms, XM, ldc, (u.aux >> 1) == 0, (u.aux >> 1) == 3, ssq}; E(acc, u, wr, wc, fr, fq); }
    }
};

__device__ __forceinline__ int scan_chunk(int dir, int k) { return dir == 0 ? k : (k < 2 ? 1 - k : 67 - k); }

__device__ __forceinline__ void phase_mod(const Args& A, unsigned char* lds) {
    float* sc = (float*)lds; float* red = sc + 5 * 1024;
    const int tid = otid();
    float* MOD = (float*)(ows(A) + WS_MOD);
    for (int i = tid; i < 5 * 1024; i += NTHR) { const float v = (i < 4096) ? oin(A, 1)[i] : oin(A, 3)[i - 4096]; sc[i] = siluf_(v); }
    __syncthreads();
    for (int item = obid(); item < 192; item += ogrid()) {
        const int l = item / 96, jb = item % 96, kp = tid >> 6, jj = tid & 63, j = jb * 64 + jj;
        const float* w = oin(A, 4) + (size_t)l * 1024 * 6144 + j;
        float a0 = 0.f, a1 = 0.f, a2 = 0.f, a3 = 0.f, a4 = 0.f;
#pragma unroll 8
        for (int k = kp * 128; k < kp * 128 + 128; ++k) { const float wv = __builtin_nontemporal_load(w + (size_t)k * 6144);
            a0 += sc[k] * wv; a1 += sc[1024 + k] * wv; a2 += sc[2048 + k] * wv; a3 += sc[3072 + k] * wv; a4 += sc[4096 + k] * wv; }
        red[(kp * 5 + 0) * 64 + jj] = a0; red[(kp * 5 + 1) * 64 + jj] = a1; red[(kp * 5 + 2) * 64 + jj] = a2; red[(kp * 5 + 3) * 64 + jj] = a3; red[(kp * 5 + 4) * 64 + jj] = a4;
        __syncthreads();
        if (tid < 320) { const int s = tid >> 6, j2 = tid & 63; float t = oin(A, 5)[l * 6144 + jb * 64 + j2];
#pragma unroll
            for (int q = 0; q < 8; ++q) t += red[(q * 5 + s) * 64 + j2];
            MOD[(size_t)(l * 5 + s) * 6144 + jb * 64 + j2] = t; }
        __syncthreads();
    }
    if (obid() == 0 && tid < 256) ((unsigned*)(ows(A) + WS_QCTR))[tid] = 0u;
    if (obid() == 0 && tid < 2) { const int l = tid; float s1 = 0.f, s2 = 0.f;
        for (int i = 0; i < 64; ++i) { s1 += oin(A, 17)[l * 64 + i] * oin(A, 18)[l * 64 + i]; s2 += oin(A, 19)[l * 64 + i] * oin(A, 20)[l * 64 + i]; }
        const float lam_init = 0.8f - 0.6f * expf(-0.3f * (float)l);
        ((float*)(ows(A) + WS_LAM))[l] = expf(s1) - expf(s2) + lam_init; }
}

struct WItem { const float* W; bf16* WT; const float* ks; int K, N, row_off, half, mode, it; };
__device__ __forceinline__ WItem wconv_desc(const Args& A, int L, int idx) {
    unsigned char* wt = ows(A) + WS_WT; WItem d; d.ks = nullptr; d.row_off = 0; d.half = 0; d.mode = 0;
    if (idx < 2000) { d.W = oin(A, 8) + (size_t)L * 1024 * 3984; d.K = 1024; d.N = 3984; d.WT = (bf16*)(wt + WT_IN); d.it = idx; }
    else if (idx < 4048) { const int i = (idx - 2000) >> 9; d.W = oin(A, 34) + (size_t)(L * 4 + i) * 1024 * 1024; d.K = 1024; d.N = 1024; d.WT = (bf16*)(wt + WT_G); d.row_off = i * 1024; d.it = (idx - 2000) & 511; }
    else if (idx < 4816) { const int j = (idx - 4048) >> 8; d.W = oin(A, j == 0 ? 35 : j == 1 ? 36 : 37) + (size_t)L * 512 * 1024; d.K = 512; d.N = 1024; d.WT = (bf16*)(wt + WT_BR + (size_t)j * 1024 * 512 * 2); d.it = (idx - 4048) & 255;
        if (j == 0) { d.mode = 2; d.ks = oin(A, 14) + L * 512; } }
    else if (idx < 5008) { d.W = oin(A, 38) + (size_t)L * 384 * 1024; d.K = 384; d.N = 1024; d.WT = (bf16*)(wt + WT_BR + (size_t)3 * 1024 * 512 * 2); d.it = idx - 4816; }
    else if (idx < 5520) { d.W = oin(A, 39) + (size_t)L * 1024 * 1024; d.K = 1024; d.N = 1024; d.WT = (bf16*)(wt + WT_O); d.it = idx - 5008; }
    else if (idx < 8336) { d.W = oin(A, 40) + (size_t)L * 1024 * 5632; d.K = 1024; d.N = 5632; d.WT = (bf16*)(wt + WT_GU); d.mode = 1; d.half = 2816; d.it = idx - 5520; }
    else if (idx < 9744) { d.W = oin(A, 41) + (size_t)L * 2816 * 1024; d.K = 2816; d.N = 1024; d.WT = (bf16*)(wt + WT_DN); d.it = idx - 8336; }
    else { d.W = oin(A, 32) + (size_t)L * 384 * 768; d.K = 384; d.N = 768; d.WT = (bf16*)(wt + WT_GLU); d.mode = 1; d.half = 384; d.it = idx - 9744; }
    return d;
}
__device__ __forceinline__ void wconv_load(const WItem& d, int lane, float (&v)[32]) {
    const int nblk = (d.N + 31) >> 5, kb = d.it / nblk, nb = d.it - kb * nblk, k0 = 64 * kb, nl = 32 * nb + (lane & 31);
#pragma unroll
    for (int i = 0; i < 32; ++i) { const int kk = 2 * i + (lane >> 5); v[i] = (nl < d.N) ? __builtin_nontemporal_load(d.W + (size_t)(k0 + kk) * d.N + nl) : 0.f; }
}
__device__ __forceinline__ void wconv_store(const WItem& d, int lane, const float (&v)[32], float* scr) {
    const int nblk = (d.N + 31) >> 5, kb = d.it / nblk, nb = d.it - kb * nblk, k0 = 64 * kb, n0 = 32 * nb;
#pragma unroll
    for (int i = 0; i < 32; ++i) scr[(2 * i + (lane >> 5)) * 33 + (lane & 31)] = v[i];
    LDSW();
    const int c = lane & 7;
#pragma unroll
    for (int j = 0; j < 4; ++j) { const int n = (lane >> 3) + 8 * j, ng = n0 + n; const float* s = scr + (8 * c) * 33 + n;
        if (ng < d.N) {
            const int orow = (d.mode == 1) ? ((ng < d.half) ? ((ng >> 7) * 256 + (ng & 127)) : (((ng - d.half) >> 7) * 256 + 128 + ((ng - d.half) & 127))) : d.row_off + ng;
            f32x4 ka = {1.f, 1.f, 1.f, 1.f}, kb2 = ka;
            if (d.mode == 2) { ka = *(const f32x4*)(d.ks + k0 + 8 * c); kb2 = *(const f32x4*)(d.ks + k0 + 8 * c + 4); }
            v4u o; o.x = pk2(s[0 * 33] * ka.x, s[1 * 33] * ka.y); o.y = pk2(s[2 * 33] * ka.z, s[3 * 33] * ka.w); o.z = pk2(s[4 * 33] * kb2.x, s[5 * 33] * kb2.y); o.w = pk2(s[6 * 33] * kb2.z, s[7 * 33] * kb2.w);
            *(v4u*)(d.WT + (size_t)orow * d.K + k0 + 8 * c) = o; } }
    LDSW();
}
__device__ __forceinline__ void phase_wconv(const Args& A, int L, unsigned char* lds) {
    const int tid = otid(), lane = tid & 63, wid = tid >> 6;
    float* scr = (float*)(lds + wid * 8704);
    const int ngw = ogrid() * 8, gw = obid() * 8 + wid;
    constexpr int NITEMS = 9888;
    for (int i = obid() * NTHR + tid; i < 112 * 1024 / 8; i += ogrid() * NTHR) ((v4u*)(ows(A) + WS_WT + WT_IN + (size_t)3984 * 1024 * 2))[i] = (v4u){0u, 0u, 0u, 0u};
    if (gw < NITEMS) {
        float v[32]; { const WItem d0 = wconv_desc(A, L, gw); wconv_load(d0, lane, v); }
        for (int idx = gw; idx < NITEMS; idx += ngw) {
            const int nidx = idx + ngw; float v2[32];
            if (nidx < NITEMS) { const WItem dn = wconv_desc(A, L, nidx); wconv_load(dn, lane, v2); }
            { const WItem dc = wconv_desc(A, L, idx); wconv_store(dc, lane, v, scr); }
#pragma unroll
            for (int i = 0; i < 32; ++i) v[i] = v2[i];
        }
    }
}

__device__ __forceinline__ void phase_norm(const Args& A, const float* lat, const float* ctx, const float* g, const float* mod, int sh_off, int sc_off, bool skipctx) {
    const int tid = otid(), lane = tid & 63, wid = tid >> 6;
    bf16* XN = (bf16*)(ows(A) + WS_XN);
    const int nw = ogrid() * 8;
    for (int r0 = obid() * 8 + wid; r0 < MALL; r0 += 2 * nw) {
        const float* src[2]; const float* mv[2]; bool ok[2]; f32x4 v[2][4];
#pragma unroll
        for (int q = 0; q < 2; ++q) { const int r = r0 + q * nw; ok[q] = r < MALL; const int rr = ok[q] ? r : r0; const int b = rr / TPB, t = rr - b * TPB;
            if (t < CTXL) { if (skipctx) ok[q] = false; src[q] = ctx + ((size_t)b * CTXL + t) * DMOD; mv[q] = mod + 4 * 6144; }
            else { src[q] = lat + ((size_t)b * SEQ + (t - CTXL)) * DMOD; mv[q] = mod + b * 6144; }
#pragma unroll
            for (int j = 0; j < 4; ++j) v[q][j] = *(const f32x4*)(src[q] + 4 * lane + 256 * j); }
#pragma unroll
        for (int q = 0; q < 2; ++q) { float ss = 0.f;
#pragma unroll
            for (int j = 0; j < 4; ++j) ss += (v[q][j].x * v[q][j].x + v[q][j].y * v[q][j].y) + (v[q][j].z * v[q][j].z + v[q][j].w * v[q][j].w);
            const float rstd = rsqrtf(wave_sum(ss) * (1.f / DMOD) + EPS);
            if (ok[q]) {
#pragma unroll
                for (int j = 0; j < 4; ++j) { const int col = 4 * lane + 256 * j; const f32x4 gg = *(const f32x4*)(g + col), sh = *(const f32x4*)(mv[q] + sh_off + col), sc = *(const f32x4*)(mv[q] + sc_off + col);
                    const f32x4 y = v[q][j] * rstd * gg * (sc + 1.f) + sh; v2u o; o.x = pk2(y.x, y.y); o.y = pk2(y.z, y.w);
                    *(v2u*)(XN + (size_t)(r0 + q * nw) * DMOD + col) = o; } } }
    }
}

__device__ __forceinline__ float dpp_sum16(float x) {
    x += __builtin_bit_cast(float, __builtin_amdgcn_update_dpp(0, __builtin_bit_cast(int, x), 0xB1, 0xF, 0xF, true));
    x += __builtin_bit_cast(float, __builtin_amdgcn_update_dpp(0, __builtin_bit_cast(int, x), 0x4E, 0xF, 0xF, true));
    x += __builtin_bit_cast(float, __builtin_amdgcn_update_dpp(0, __builtin_bit_cast(int, x), 0x141, 0xF, 0xF, true));
    x += __builtin_bit_cast(float, __builtin_amdgcn_update_dpp(0, __builtin_bit_cast(int, x), 0x140, 0xF, 0xF, true));
    return x;
}
__device__ __forceinline__ void phase_prep(const Args& A, int L) {
    const int tid = otid(), lane = tid & 63, wid = tid >> 6;
    bf16* P = (bf16*)(ows(A) + WS_P); bf16* XBC = (bf16*)(ows(A) + WS_XBC); float* DT = (float*)(ows(A) + WS_DT);
    {
        const float* dtb = oin(A, 12) + L * 16;
        for (int idx = obid() * NTHR + tid; idx < MALL * 16; idx += ogrid() * NTHR) { const int r = idx >> 4, j = idx & 15;
            const float raw = bf2f(P[(size_t)r * PW + PC_DT + j]) + dtb[j]; DT[idx] = raw > 20.f ? raw : log1pf(expf(raw)); }
    }
    if (tid < 480) {
        const int cg = tid % 96, tsub = tid / 96; const float* cw = oin(A, 9) + (size_t)L * 5 * 768 + cg * 8; const float* cb = oin(A, 10) + L * 768 + cg * 8;
        float w[5][8], bias[8];
#pragma unroll
        for (int j = 0; j < 5; ++j) { const f32x4 a = *(const f32x4*)(cw + j * 768), b = *(const f32x4*)(cw + j * 768 + 4);
            w[j][0] = a.x; w[j][1] = a.y; w[j][2] = a.z; w[j][3] = a.w; w[j][4] = b.x; w[j][5] = b.y; w[j][6] = b.z; w[j][7] = b.w; }
        { const f32x4 a = *(const f32x4*)cb, b = *(const f32x4*)(cb + 4); bias[0] = a.x; bias[1] = a.y; bias[2] = a.z; bias[3] = a.w; bias[4] = b.x; bias[5] = b.y; bias[6] = b.z; bias[7] = b.w; }
        const int cstep = ogrid() * 5;
        for (int rbase = obid() * 5 + tsub; rbase < MALL; rbase += 2 * cstep) {
            v4u xin[2][5]; bool okk[2][5];
#pragma unroll
            for (int q = 0; q < 2; ++q) { const int r = rbase + q * cstep; const int rr = r < MALL ? r : rbase; const int t = rr % TPB; const int seg_lo = (t < CTXL) ? 0 : CTXL, seg_hi = (t < CTXL) ? CTXL : TPB;
#pragma unroll
                for (int j = 0; j < 5; ++j) { const int tt = t + j - 2; okk[q][j] = (tt >= seg_lo && tt < seg_hi);
                    xin[q][j] = okk[q][j] ? *(const v4u*)(P + (size_t)(rr + j - 2) * PW + PC_XBC + cg * 8) : (v4u){0u, 0u, 0u, 0u}; } }
#pragma unroll
            for (int q = 0; q < 2; ++q) { const int r = rbase + q * cstep;
                float acc[8];
#pragma unroll
                for (int e = 0; e < 8; ++e) acc[e] = bias[e];
#pragma unroll
                for (int j = 0; j < 5; ++j) { const v4u x = xin[q][j];
                    acc[0] += w[j][0] * bflo(x.x); acc[1] += w[j][1] * bfhi(x.x); acc[2] += w[j][2] * bflo(x.y); acc[3] += w[j][3] * bfhi(x.y);
                    acc[4] += w[j][4] * bflo(x.z); acc[5] += w[j][5] * bfhi(x.z); acc[6] += w[j][6] * bflo(x.w); acc[7] += w[j][7] * bfhi(x.w); }
                v4u o; o.x = pk2(siluf_(acc[0]), siluf_(acc[1])); o.y = pk2(siluf_(acc[2]), siluf_(acc[3])); o.z = pk2(siluf_(acc[4]), siluf_(acc[5])); o.w = pk2(siluf_(acc[6]), siluf_(acc[7]));
                if (r < MALL) *(v4u*)(XBC + (size_t)r * 768 + cg * 8) = o; }
        }
    }
    {
        const int sub = lane >> 4, li = lane & 15, base = (li < 8) ? 2 * li : 32 + 2 * (li - 8);
        float g[4][4];
#pragma unroll
        for (int ty = 0; ty < 4; ++ty) { const float* gp = oin(A, ty == 0 ? 15 : ty == 1 ? 16 : ty == 2 ? 22 : 23) + L * 64 + base; g[ty][0] = gp[0]; g[ty][1] = gp[1]; g[ty][2] = gp[16]; g[ty][3] = gp[17]; }
        const float if0 = powf(10000.f, -(float)(base & 15) / 16.f), if1 = powf(10000.f, -(float)((base + 1) & 15) / 16.f);
        const int nw = ogrid() * 8;
        for (int rbase = obid() * 8 + wid; rbase < MALL; rbase += 2 * nw) {
            unsigned ra[2][7], rb[2][7]; float c0[2], s0[2], c1[2], s1[2]; bf16* prow[2]; bool okr[2];
#pragma unroll
            for (int q = 0; q < 2; ++q) { const int r = rbase + q * nw; okr[q] = r < MALL; const int rr = okr[q] ? r : rbase; prow[q] = P + (size_t)rr * PW;
#pragma unroll
                for (int it = 0; it < 7; ++it) { const int hd = it * 4 + sub; const int hc = hd < 26 ? hd : 25;
                    const int cc = (hc < 8) ? PC_DQ + hc * 64 : (hc < 16) ? PC_DK + (hc - 8) * 64 : (hc < 24) ? PC_GQ + (hc - 16) * 64 : PC_GK + (hc - 24) * 64;
                    ra[q][it] = *(const unsigned*)(prow[q] + cc + base); rb[q][it] = *(const unsigned*)(prow[q] + cc + base + 16); } }
#pragma unroll
            for (int q = 0; q < 2; ++q) { const int r = rbase + q * nw; const int t = (r < MALL ? r : rbase) % TPB;
                c0[q] = 1.f; s0[q] = 0.f; c1[q] = 1.f; s1[q] = 0.f;
                if (t >= CTXL) { const int tl = t - CTXL; const float pos = (float)((li < 8) ? (tl >> 6) : (tl & 63)); sincosf(pos * if0, &s0[q], &c0[q]); sincosf(pos * if1, &s1[q], &c1[q]); } }
#pragma unroll
            for (int q = 0; q < 2; ++q) {
#pragma unroll
                for (int it = 0; it < 7; ++it) { const int hd = it * 4 + sub; const int hc = hd < 26 ? hd : 25;
                    const int cc = (hc < 8) ? PC_DQ + hc * 64 : (hc < 16) ? PC_DK + (hc - 8) * 64 : (hc < 24) ? PC_GQ + (hc - 16) * 64 : PC_GK + (hc - 24) * 64;
                    const int ty = (hc < 8) ? 0 : (hc < 16) ? 1 : (hc < 24) ? 2 : 3; const float scl = (ty == 0 || ty == 2) ? QSCALE : 1.f;
                    const float a0 = bflo(ra[q][it]), a1 = bfhi(ra[q][it]), b0 = bflo(rb[q][it]), b1 = bfhi(rb[q][it]);
                    const float ss = dpp_sum16((a0 * a0 + a1 * a1) + (b0 * b0 + b1 * b1));
                    const float rs = rsqrtf(ss * (1.f / 64.f) + EPS) * scl;
                    const float g0 = ty == 0 ? g[0][0] : ty == 1 ? g[1][0] : ty == 2 ? g[2][0] : g[3][0], g1 = ty == 0 ? g[0][1] : ty == 1 ? g[1][1] : ty == 2 ? g[2][1] : g[3][1];
                    const float g2 = ty == 0 ? g[0][2] : ty == 1 ? g[1][2] : ty == 2 ? g[2][2] : g[3][2], g3 = ty == 0 ? g[0][3] : ty == 1 ? g[1][3] : ty == 2 ? g[2][3] : g[3][3];
                    const float ya0 = a0 * rs * g0, ya1 = a1 * rs * g1, yb0 = b0 * rs * g2, yb1 = b1 * rs * g3;
                    if (hd < 26 && okr[q]) { *(unsigned*)(prow[q] + cc + base) = pk2(ya0 * c0[q] - yb0 * s0[q], ya1 * c1[q] - yb1 * s1[q]); *(unsigned*)(prow[q] + cc + base + 16) = pk2(yb0 * c0[q] + ya0 * s0[q], yb1 * c1[q] + ya1 * s1[q]); } } }
        }
    }
}

__device__ __forceinline__ void s5_coef(const Args& A, int L, int dir, int g, int p, float& ar, float& ai, f32x2 (&bb)[16]) {
    const int idx = ((L * 2 + dir) * 24 + g) * 64 + p;
    const float lr = oin(A, 24)[idx], li = oin(A, 25)[idx], step = expf(oin(A, 26)[(L * 2 + dir) * 24 + g]);
    const float mag = expf(lr * step); float s, c; sincosf(li * step, &s, &c); ar = mag * c; ai = mag * s;
    const float den = lr * lr + li * li, fr = ((ar - 1.f) * lr + ai * li) / den, fi = (ai * lr - (ar - 1.f) * li) / den;
    const float* br = oin(A, 27) + (size_t)((L * 24 + g) * 64 + p) * 16; const float* bi = oin(A, 28) + (size_t)((L * 24 + g) * 64 + p) * 16;
#pragma unroll
    for (int c4 = 0; c4 < 4; ++c4) { const f32x4 r4 = *(const f32x4*)(br + 4 * c4), i4 = *(const f32x4*)(bi + 4 * c4);
#pragma unroll
        for (int e = 0; e < 4; ++e) bb[c4 * 4 + e] = (f32x2){fr * r4[e] - fi * i4[e], fr * i4[e] + fi * r4[e]}; }
}
__device__ __forceinline__ void s5_stage_u(const bf16* P, int r0, int g, unsigned char* us, int lane) {
#pragma unroll
    for (int q = 0; q < 2; ++q) { const int tok = lane * 2 + q; const v4u* src = (const v4u*)(P + (size_t)(r0 + tok) * PW + PC_U + g * 16);
        ((v4u*)us)[tok * 2] = src[0]; ((v4u*)us)[tok * 2 + 1] = src[1]; }
    LDSW();
}
__device__ __forceinline__ void s5_setup(const Args& A, int L, int dir, int g, int lane, unsigned char* BT, float& ar, float& ai, bf16x8 (&bfr)[8]) {
    f32x2 bb[16]; s5_coef(A, L, dir, g, lane, ar, ai, bb);
#pragma unroll
    for (int c2 = 0; c2 < 8; ++c2) { *(unsigned*)(BT + (2 * lane) * 32 + c2 * 4) = pk2(bb[2 * c2].x, bb[2 * c2 + 1].x); *(unsigned*)(BT + (2 * lane + 1) * 32 + c2 * 4) = pk2(bb[2 * c2].y, bb[2 * c2 + 1].y); }
    LDSW();
    const int fr = lane & 15, fq = lane >> 4; const bf16x8 z8 = {0, 0, 0, 0, 0, 0, 0, 0};
#pragma unroll
    for (int ct = 0; ct < 8; ++ct) bfr[ct] = (fq < 2) ? *(const bf16x8*)(BT + (ct * 16 + fr) * 32 + fq * 16) : z8;
    LDSW();
}
__device__ __forceinline__ void s5_bu16(const unsigned char* us, unsigned char* BuS, int tokf, const bf16x8 (&bfr)[8], int fr, int fq) {
    const bf16x8 z8 = {0, 0, 0, 0, 0, 0, 0, 0};
    const bf16x8 af = (fq < 2) ? *(const bf16x8*)(us + tokf * 32 + fq * 16) : z8;
#pragma unroll
    for (int ct = 0; ct < 8; ++ct) { const f32x4 d = __builtin_amdgcn_mfma_f32_16x16x32_bf16(af, bfr[ct], (f32x4){0.f, 0.f, 0.f, 0.f}, 0, 0, 0);
#pragma unroll
        for (int j = 0; j < 4; ++j) *(bf16*)(BuS + (4 * fq + j) * 264 + (ct * 16 + fr) * 2) = (bf16)f2bf(d[j]); }
    LDSW();
}

__device__ __forceinline__ void phase_s1(const Args& A, int L, unsigned char* lds) {
    const int tid = otid(), lane = tid & 63, wid = tid >> 6;
    const bf16* XBC = (const bf16*)(ows(A) + WS_XBC); const float* DT = (const float*)(ows(A) + WS_DT);
    bf16* SST = (bf16*)(ows(A) + WS_SST); float* DEC = (float*)(ows(A) + WS_DEC);
    { const int hb = wid >> 2, wl = wid & 3, tl = tid & 255;
      unsigned char* XT = lds + hb * 36864; unsigned char* BT = XT + 17408; float* wgt = (float*)(XT + 34816);
      for (int item0 = obid() * 2; item0 < NB * 2 * NCH * 8; item0 += ogrid() * 2) {
        const int item = item0 + hb;
        const int h = item & 7, c = (item >> 3) % NCH, dir = (item / (8 * NCH)) & 1, b = item / (16 * NCH), g = h >> 2;
        const int r0 = b * TPB + c * 128;
        if (wl == 0) {
            const int i0 = 2 * lane, tA = dir ? 127 - i0 : i0, tB = dir ? 126 - i0 : i0 + 1;
            const float dA = DT[(size_t)(r0 + tA) * 16 + dir * 8 + h], dB = DT[(size_t)(r0 + tB) * 16 + dir * 8 + h];
            const float aneg = -expf(oin(A, 11)[L * 16 + dir * 8 + h]); const float a0 = dA * aneg, a1 = dB * aneg;
            float sc = a0 + a1;
#pragma unroll
            for (int o = 1; o < 64; o <<= 1) { const float t = __shfl_up(sc, o); if (lane >= o) sc += t; }
            const float tot = __shfl(sc, 63);
            wgt[tA] = expf(tot - (sc - a1)) * dA; wgt[tB] = expf(tot - sc) * dB;
            if (lane == 63) DEC[((b * 2 + dir) * NCH + c) * 8 + h] = expf(tot);
        }
        v4u xv[4], bv[4];
        { const int tok = tl >> 1, part = tl & 1;
          const v4u* xs = (const v4u*)(XBC + (size_t)(r0 + tok) * 768 + h * 64 + part * 32); const v4u* bs = (const v4u*)(XBC + (size_t)(r0 + tok) * 768 + 512 + g * 64 + part * 32);
#pragma unroll
          for (int q = 0; q < 4; ++q) { xv[q] = xs[q]; bv[q] = bs[q]; } }
        __syncthreads();
        { const int tok = tl >> 1, part = tl & 1; const float w = wgt[tok];
#pragma unroll
          for (int q = 0; q < 4; ++q) { const unsigned xa[4] = {xv[q].x, xv[q].y, xv[q].z, xv[q].w}, ba[4] = {bv[q].x, bv[q].y, bv[q].z, bv[q].w};
#pragma unroll
              for (int e4 = 0; e4 < 4; ++e4) { const int p = part * 32 + q * 8 + e4 * 2;
                  *(bf16*)(XT + p * 272 + tok * 2) = (bf16)f2bf(bflo(xa[e4]) * w); *(bf16*)(XT + (p + 1) * 272 + tok * 2) = (bf16)f2bf(bfhi(xa[e4]) * w);
                  *(bf16*)(BT + p * 272 + tok * 2) = (bf16)(ba[e4] & 0xffffu); *(bf16*)(BT + (p + 1) * 272 + tok * 2) = (bf16)(ba[e4] >> 16); } } }
        __syncthreads();
        { const int pi = wl; bf16* dst = SST + ((size_t)(((b * 2 + dir) * NCH + c) * 8 + h)) * 4096;
#pragma unroll
          for (int ni = 0; ni < 4; ++ni) { f32x4 acc = {0.f, 0.f, 0.f, 0.f};
#pragma unroll
              for (int kk = 0; kk < 4; ++kk) { const bf16x8 af = *(const bf16x8*)(XT + (pi * 16 + (lane & 15)) * 272 + (kk * 32 + 8 * (lane >> 4)) * 2);
                  const bf16x8 bf = *(const bf16x8*)(BT + (ni * 16 + (lane & 15)) * 272 + (kk * 32 + 8 * (lane >> 4)) * 2);
                  acc = __builtin_amdgcn_mfma_f32_16x16x32_bf16(af, bf, acc, 0, 0, 0); }
#pragma unroll
              for (int j = 0; j < 4; ++j) dst[(pi * 16 + 4 * (lane >> 4) + j) * 64 + ni * 16 + (lane & 15)] = (bf16)f2bf(acc[j]); } }
        __syncthreads();
      }
    }
    const bf16* P = (const bf16*)(ows(A) + WS_P); float* S5 = (float*)(ows(A) + WS_S5);
    unsigned char* us = lds + wid * 8320; unsigned char* BuS = us + 4096;
    const int fr = lane & 15, fq = lane >> 4;
    for (int item = obid() * 8 + wid; item < NB * 2 * NCH * 24; item += ogrid() * 8) {
        const int g = item % 24, c = (item / 24) % NCH, dir = (item / (24 * NCH)) & 1, b = item / (48 * NCH);
        float ar, ai; bf16x8 bfr[8]; s5_setup(A, L, dir, g, lane, BuS, ar, ai, bfr);
        s5_stage_u(P, b * TPB + c * 128, g, us, lane);
        float hr = 0.f, hi = 0.f;
#pragma unroll 1
        for (int sb = 0; sb < 8; ++sb) { s5_bu16(us, BuS, dir ? 127 - (sb * 16 + fr) : sb * 16 + fr, bfr, fr, fq);
#pragma unroll
            for (int ii = 0; ii < 16; ++ii) { const unsigned w = *(const unsigned*)(BuS + ii * 264 + lane * 4);
                const float nr = ar * hr - ai * hi + bflo(w), ni = ar * hi + ai * hr + bfhi(w); hr = nr; hi = ni; }
            LDSW(); }
        *(f32x2*)(S5 + ((size_t)(((b * 2 + dir) * NCH + c) * 24 + g) * 64 + lane) * 2) = (f32x2){hr, hi};
    }
}

__device__ __forceinline__ void phase_s2(const Args& A, int L) {
    const int tid = otid();
    bf16* SST = (bf16*)(ows(A) + WS_SST); const float* DEC = (const float*)(ows(A) + WS_DEC);
    for (int gt = obid() * NTHR + tid; gt < NB * 2 * 8 * 2048; gt += ogrid() * NTHR) {
        const int e2 = gt & 2047, h = (gt >> 11) & 7, dir = (gt >> 14) & 1, b = gt >> 15;
        float r0 = 0.f, r1 = 0.f;
#pragma unroll 1
        for (int kb = 0; kb < NCH; kb += 11) { unsigned vv[11]; float dd[11];
#pragma unroll
            for (int q = 0; q < 11; ++q) { const int c = scan_chunk(dir, kb + q); const size_t ci = (size_t)((b * 2 + dir) * NCH + c) * 8 + h; vv[q] = *(const unsigned*)(SST + ci * 4096 + e2 * 2); dd[q] = DEC[ci]; }
#pragma unroll
            for (int q = 0; q < 11; ++q) { const int c = scan_chunk(dir, kb + q); const size_t ci = (size_t)((b * 2 + dir) * NCH + c) * 8 + h;
                *(unsigned*)(SST + ci * 4096 + e2 * 2) = pk2(r0, r1); r0 = r0 * dd[q] + bflo(vv[q]); r1 = r1 * dd[q] + bfhi(vv[q]); } }
    }
    float* S5 = (float*)(ows(A) + WS_S5);
    for (int gt = obid() * NTHR + tid; gt < NB * 2 * 24 * 64; gt += ogrid() * NTHR) {
        const int p = gt & 63, g = (gt >> 6) % 24, dir = (gt / (64 * 24)) & 1, b = gt / (64 * 48);
        const int idx = ((L * 2 + dir) * 24 + g) * 64 + p;
        const float lr = oin(A, 24)[idx], li = oin(A, 25)[idx], step = expf(oin(A, 26)[(L * 2 + dir) * 24 + g]);
        const float mag = expf(lr * step); float s, c0; sincosf(li * step, &s, &c0); float pr = mag * c0, pi = mag * s;
#pragma unroll
        for (int q = 0; q < 7; ++q) { const float nr = pr * pr - pi * pi, ni = 2.f * pr * pi; pr = nr; pi = ni; }
        float hr = 0.f, hi = 0.f;
#pragma unroll 1
        for (int kb = 0; kb < NCH; kb += 11) { f32x2 vv[11];
#pragma unroll
            for (int q = 0; q < 11; ++q) { const int c = scan_chunk(dir, kb + q); vv[q] = *(const f32x2*)(S5 + ((size_t)(((b * 2 + dir) * NCH + c) * 24 + g) * 64 + p) * 2); }
#pragma unroll
            for (int q = 0; q < 11; ++q) { const int c = scan_chunk(dir, kb + q);
                *(f32x2*)(S5 + ((size_t)(((b * 2 + dir) * NCH + c) * 24 + g) * 64 + p) * 2) = (f32x2){hr, hi};
                const float nr = pr * hr - pi * hi + vv[q].x, ni = pr * hi + pi * hr + vv[q].y; hr = nr; hi = ni; } }
    }
}

__device__ __forceinline__ void ssd_out_item(const Args& A, int L, int b, int c, int g, unsigned char* lds) {
    const int tid = otid(), lane = tid & 63, wid = tid >> 6, fr = lane & 15, fq = lane >> 4;
    const bf16* XBC = (const bf16*)(ows(A) + WS_XBC); const float* DT = (const float*)(ows(A) + WS_DT); const bf16* SST = (const bf16*)(ows(A) + WS_SST);
    bf16* P = (bf16*)(ows(A) + WS_P); float* SSQ = (float*)(ows(A) + WS_SSQ);
    float* acum = (float*)lds; float* dtv = (float*)(lds + 4096); unsigned char* XT = lds + 8192; unsigned char* Wst = lds + 8192 + 17408 + wid * 4352;
    const int r0 = b * TPB + c * 128;
    { const int dir = wid >> 2, hh = wid & 3, h = g * 4 + hh; const int t0 = 2 * lane;
        const float d0 = DT[(size_t)(r0 + t0) * 16 + dir * 8 + h], d1 = DT[(size_t)(r0 + t0 + 1) * 16 + dir * 8 + h];
        const float aneg = -expf(oin(A, 11)[L * 16 + dir * 8 + h]); const float a0 = d0 * aneg, a1 = d1 * aneg;
        float sc = a0 + a1;
#pragma unroll
        for (int o = 1; o < 64; o <<= 1) { const float t = __shfl_up(sc, o); if (lane >= o) sc += t; }
        const float tot = __shfl(sc, 63);
        float c0v, c1v;
        if (dir == 0) { c0v = sc - a1; c1v = sc; } else { c0v = tot - (sc - a1) + a0; c1v = tot - sc + a1; }
        acum[wid * 128 + t0] = c0v; acum[wid * 128 + t0 + 1] = c1v; dtv[wid * 128 + t0] = d0; dtv[wid * 128 + t0 + 1] = d1; }
    float ssq[4] = {0.f, 0.f, 0.f, 0.f};
    const int trow = 16 * wid;
    bf16x8 cf[2]; f32x4 G[8];
#pragma unroll
    for (int kk = 0; kk < 2; ++kk) cf[kk] = *(const bf16x8*)(XBC + (size_t)(r0 + trow + fr) * 768 + 640 + g * 64 + kk * 32 + 8 * fq);
#pragma unroll
    for (int si = 0; si < 8; ++si) { G[si] = (f32x4){0.f, 0.f, 0.f, 0.f};
#pragma unroll
        for (int kk = 0; kk < 2; ++kk) { const bf16x8 bfr = *(const bf16x8*)(XBC + (size_t)(r0 + si * 16 + fr) * 768 + 512 + g * 64 + kk * 32 + 8 * fq);
            G[si] = __builtin_amdgcn_mfma_f32_16x16x32_bf16(cf[kk], bfr, G[si], 0, 0, 0); } }
#pragma unroll 1
    for (int hh = 0; hh < 4; ++hh) { const int h = g * 4 + hh;
        __syncthreads();
        { const int tok = tid >> 2, part = tid & 3; const v4u* xs = (const v4u*)(XBC + (size_t)(r0 + tok) * 768 + h * 64 + part * 16);
#pragma unroll
          for (int q = 0; q < 2; ++q) { const v4u xv = xs[q]; const unsigned xa[4] = {xv.x, xv.y, xv.z, xv.w};
#pragma unroll
              for (int e = 0; e < 4; ++e) { const int p = part * 16 + q * 8 + e * 2;
                  *(bf16*)(XT + p * 272 + tok * 2) = (bf16)(xa[e] & 0xffffu); *(bf16*)(XT + (p + 1) * 272 + tok * 2) = (bf16)(xa[e] >> 16); } } }
        unsigned short zv[4][4];
        { const bf16* zq = P + (size_t)(r0 + trow + 4 * fq) * PW + PC_Z + h * 64 + fr;
#pragma unroll
          for (int pi = 0; pi < 4; ++pi)
#pragma unroll
              for (int j = 0; j < 4; ++j) zv[pi][j] = zq[(size_t)j * PW + pi * 16]; }
        __syncthreads();
        f32x4 acc[4];
#pragma unroll
        for (int pi = 0; pi < 4; ++pi) acc[pi] = (f32x4){0.f, 0.f, 0.f, 0.f};
#pragma unroll 1
        for (int dir = 0; dir < 2; ++dir) { const float* ac = acum + (dir * 4 + hh) * 128; const float* dv = dtv + (dir * 4 + hh) * 128;
            const bf16* hs = SST + ((size_t)(((b * 2 + dir) * NCH + c) * 8 + h)) * 4096;
            bf16x8 hf[4][2];
#pragma unroll
            for (int pi = 0; pi < 4; ++pi)
#pragma unroll
                for (int kk = 0; kk < 2; ++kk) hf[pi][kk] = *(const bf16x8*)(hs + (pi * 16 + fr) * 64 + kk * 32 + 8 * fq);
            float at[4];
#pragma unroll
            for (int j = 0; j < 4; ++j) at[j] = ac[trow + 4 * fq + j];
#pragma unroll
            for (int si = 0; si < 8; ++si) { const int s = si * 16 + fr; const float as = ac[s], ds = dv[s];
#pragma unroll
                for (int j = 0; j < 4; ++j) { const int t = trow + 4 * fq + j; const bool ok = dir ? (s >= t) : (s <= t);
                    const float w = ok ? G[si][j] * __expf(at[j] - as) * ds : 0.f;
                    *(bf16*)(Wst + (4 * fq + j) * 272 + s * 2) = (bf16)f2bf(w); } }
            LDSW();
            bf16x8 wf[4];
#pragma unroll
            for (int kk = 0; kk < 4; ++kk) wf[kk] = *(const bf16x8*)(Wst + fr * 272 + (kk * 32 + 8 * fq) * 2);
#pragma unroll
            for (int pi = 0; pi < 4; ++pi) {
#pragma unroll
                for (int kk = 0; kk < 4; ++kk) { const bf16x8 xf = *(const bf16x8*)(XT + (pi * 16 + fr) * 272 + (kk * 32 + 8 * fq) * 2);
                    acc[pi] = __builtin_amdgcn_mfma_f32_16x16x32_bf16(wf[kk], xf, acc[pi], 0, 0, 0); }
                f32x4 yo = {0.f, 0.f, 0.f, 0.f};
#pragma unroll
                for (int kk = 0; kk < 2; ++kk) yo = __builtin_amdgcn_mfma_f32_16x16x32_bf16(cf[kk], hf[pi][kk], yo, 0, 0, 0);
#pragma unroll
                for (int j = 0; j < 4; ++j) acc[pi][j] += __expf(at[j]) * yo[j]; }
            LDSW();
        }
        const float dh = oin(A, 13)[L * 8 + h];
        { bf16* zq = P + (size_t)(r0 + trow + 4 * fq) * PW + PC_Z + h * 64 + fr;
#pragma unroll
          for (int pi = 0; pi < 4; ++pi)
#pragma unroll
              for (int j = 0; j < 4; ++j) { const float x = bf2f(*(const bf16*)(XT + (pi * 16 + fr) * 272 + (trow + 4 * fq + j) * 2)), z = bf2f(zv[pi][j]);
                  const float v = (acc[pi][j] + dh * x) * siluf_(z); ssq[j] += v * v; zq[(size_t)j * PW + pi * 16] = (bf16)f2bf(v); } }
    }
#pragma unroll
    for (int j = 0; j < 4; ++j) { float s = ssq[j]; s += __shfl_xor(s, 1); s += __shfl_xor(s, 2); s += __shfl_xor(s, 4); s += __shfl_xor(s, 8);
        if (fr == 0) SSQ[(size_t)(r0 + trow + 4 * fq + j) * 2 + g] = s; }
    __syncthreads();
}

__device__ __forceinline__ void s5_out_item(const Args& A, int L, int b, int g, int c, unsigned char* wl) {
    const int lane = otid() & 63, fr = lane & 15, fq = lane >> 4;
    bf16* P = (bf16*)(ows(A) + WS_P); const float* S5 = (const float*)(ows(A) + WS_S5);
    unsigned char* us = wl; bf16* yl = (bf16*)(wl + 4096); unsigned char* Hs = wl + 8192; unsigned char* BuS = wl + 12544;
    const int r0 = b * TPB + c * 128;
    s5_stage_u(P, r0, g, us, lane);
    const float dsk = oin(A, 31)[L * 384 + g * 16 + fr];
#pragma unroll 1
    for (int dir = 0; dir < 2; ++dir) {
        float ar, ai; bf16x8 bfr[8]; s5_setup(A, L, dir, g, lane, Hs, ar, ai, bfr);
        const f32x2 h0 = *(const f32x2*)(S5 + ((size_t)(((b * 2 + dir) * NCH + c) * 24 + g) * 64 + lane) * 2);
        float hr = h0.x, hi = h0.y;
        bf16x8 cfr[4];
#pragma unroll
        for (int kk = 0; kk < 4; ++kk) { const int p0 = kk * 16 + 4 * fq;
            const f32x4 cr = *(const f32x4*)(oin(A, 29) + (size_t)((L * 24 + g) * 16 + fr) * 64 + p0), ci = *(const f32x4*)(oin(A, 30) + (size_t)((L * 24 + g) * 16 + fr) * 64 + p0);
            v4u w; w.x = pk2(cr[0], -ci[0]); w.y = pk2(cr[1], -ci[1]); w.z = pk2(cr[2], -ci[2]); w.w = pk2(cr[3], -ci[3]); cfr[kk] = __builtin_bit_cast(bf16x8, w); }
#pragma unroll 1
        for (int sb = 0; sb < 8; ++sb) {
            s5_bu16(us, BuS, dir ? 127 - (sb * 16 + fr) : sb * 16 + fr, bfr, fr, fq);
#pragma unroll
            for (int ii = 0; ii < 16; ++ii) { const unsigned w = *(const unsigned*)(BuS + ii * 264 + lane * 4);
                const float nr = ar * hr - ai * hi + bflo(w), ni = ar * hi + ai * hr + bfhi(w); hr = nr; hi = ni;
                *(unsigned*)(Hs + ii * 272 + lane * 4) = pk2(hr, hi); }
            LDSW();
            f32x4 y = {0.f, 0.f, 0.f, 0.f};
#pragma unroll
            for (int kk = 0; kk < 4; ++kk) { const bf16x8 af = *(const bf16x8*)(Hs + fr * 272 + (kk * 32 + 8 * fq) * 2); y = __builtin_amdgcn_mfma_f32_16x16x32_bf16(af, cfr[kk], y, 0, 0, 0); }
#pragma unroll
            for (int j = 0; j < 4; ++j) { const int i = sb * 16 + 4 * fq + j, tok = dir ? 127 - i : i;
                if (dir == 0) yl[tok * 16 + fr] = (bf16)f2bf(y[j]);
                else { float v = bf2f(yl[tok * 16 + fr]) + y[j] + dsk * bf2f(*(const bf16*)(us + tok * 32 + fr * 2));
                    { const float u_ = 0.7978845608028654f * (v + 0.044715f * v * v * v); v = v * (1.f - __builtin_amdgcn_rcpf(1.f + __expf(2.f * u_))); }
                    P[(size_t)(r0 + tok) * PW + PC_U + g * 16 + fr] = (bf16)f2bf(v); } }
            LDSW();
        }
    }
}

__device__ __forceinline__ void attn_vcu(const Args& A, int L, int v, bool ctx_out, unsigned char* lds) {
    using abf = attn_body::bf16;
    abf* P = (abf*)(ows(A) + WS_P); abf* YB = (abf*)(ows(A) + WS_YB);
    const float lam = ((const float*)(ows(A) + WS_LAM))[L];
    char* shm = (char*)lds;
    const int xcd = v & 7, qb = v >> 3;
#pragma unroll 1
    for (int j = (ctx_out && v < 48) ? 0 : 3; j < 11; ++j) {
        int b, isdiff, m = 0, h = 0, hq = 0, NT = TPB / 64; size_t rq;
        if (j < 3) { b = v / 12; const int kind = v % 12; rq = (size_t)b * TPB; NT = 4;
            if (kind < 4) { if (j == 2) continue; isdiff = 1; m = j; h = kind; } else { if (j > 0) continue; isdiff = 0; hq = kind - 4; } }
        else if (j < 7) { const int i = (j - 3) >> 1, combo = xcd + 8 * i; m = (j - 3) & 1; b = combo >> 2; h = combo & 3; isdiff = 1; rq = (size_t)b * TPB + CTXL + (size_t)qb * 256; }
        else { const int combo = xcd * 4 + (j - 7); b = combo >> 3; hq = combo & 7; isdiff = 0; rq = (size_t)b * TPB + CTXL + (size_t)qb * 256; }
        const size_t rb = (size_t)b * TPB;
#if defined(PROBE_ATTN) && PROBE_ATTN == 2
        if (!isdiff) attn_body::attn_unit<8, 1>(0, P + rq * PW + PC_GQ + hq * 64, P + rb * PW + PC_GK + (hq >> 2) * 64, P + rb * PW + PC_GV + (hq >> 2) * 64, (abf*)(ows(A) + 505 * MiB), 0, NT, 0.f, shm);
#endif
#if defined(PROBE_ATTN) && PROBE_ATTN == 1
        if (isdiff && m == 1) { attn_body::attn_unit<16, 2>(1, P + rq * PW + PC_DQ + (h * 2) * 64, P + rb * PW + PC_DK + (h * 2) * 64, P + rb * PW + PC_DV + h * 128, YB + rq * 512 + h * 128, 512, NT, lam, shm); }
#endif
        if (isdiff) attn_body::attn_unit<16, 2>(1 + m, P + rq * PW + PC_DQ + (h * 2 + m) * 64, P + rb * PW + PC_DK + (h * 2 + m) * 64, P + rb * PW + PC_DV + h * 128, YB + rq * 512 + h * 128, 512, NT, lam, shm);
        else attn_body::attn_unit<8, 1>(0, P + rq * PW + PC_GQ + hq * 64, P + rb * PW + PC_GK + (hq >> 2) * 64, P + rb * PW + PC_GV + (hq >> 2) * 64, P + rq * PW + PC_GQ + hq * 64, PW, NT, 0.f, shm);
    }
}

__device__ __forceinline__ void phase_s3(const Args& A, int L, bool ctx_out, unsigned char* lds) {
    const int c_lo = ctx_out ? 0 : 2, ncs = NCH - c_lo;
    for (int v = obid(); v < 256; v += ogrid()) attn_vcu(A, L, v, ctx_out, lds);
    __syncthreads();
    const int tid = otid(), wid = tid >> 6;
    unsigned* ctr = (unsigned*)(ows(A) + WS_QCTR) + L * 64;
    volatile unsigned* slot = (volatile unsigned*)(lds + LDS_TOTAL - 16);
    const int n_ssd = NB * ncs * 2, n_s5b = NB * 24 * ncs / 8;
    for (;;) {
        if (tid == 0) *slot = __hip_atomic_fetch_add(ctr, 1u, __ATOMIC_RELAXED, __HIP_MEMORY_SCOPE_AGENT);
        __syncthreads();
        const int q = (int)*slot;
        __syncthreads();
        if (q >= n_ssd + n_s5b) break;
        if (q < n_ssd) ssd_out_item(A, L, (q >> 1) / ncs, c_lo + (q >> 1) % ncs, q & 1, lds);
        else { const int item = (q - n_ssd) * 8 + wid; const int c = c_lo + item % ncs, g = (item / ncs) % 24, b = item / (ncs * 24);
            s5_out_item(A, L, b, g, c, lds + wid * 16768); __syncthreads(); }
    }
}

__device__ __forceinline__ void phase_s4(const Args& A, int L, bool ctx_out, unsigned char* lds) {
    const int tid = otid(), lane = tid & 63, wid = tid >> 6;
    bf16* YB = (bf16*)(ows(A) + WS_YB);
    const float lam_init = 0.8f - 0.6f * expf(-0.3f * (float)L);
    const float g0 = oin(A, 21)[L * 128 + 2 * lane] * (1.f - lam_init), g1 = oin(A, 21)[L * 128 + 2 * lane + 1] * (1.f - lam_init);
    const int nw = ogrid() * 8;
    for (int r0 = obid() * 8 + wid; r0 < MALL; r0 += 2 * nw) {
        unsigned vin[2][4]; bool ok[2];
#pragma unroll
        for (int q = 0; q < 2; ++q) { const int r = r0 + q * nw; ok[q] = (r < MALL) && (ctx_out || (r % TPB) >= CTXL); const int rr = (r < MALL) ? r : r0;
#pragma unroll
            for (int h = 0; h < 4; ++h) vin[q][h] = *(const unsigned*)(YB + (size_t)rr * 512 + h * 128 + 2 * lane); }
#pragma unroll
        for (int q = 0; q < 2; ++q)
#pragma unroll
            for (int h = 0; h < 4; ++h) { const float a = bflo(vin[q][h]), b2 = bfhi(vin[q][h]);
                const float rs = rsqrtf(wave_sum(a * a + b2 * b2) * (1.f / 128.f) + EPS);
                if (ok[q]) *(unsigned*)(YB + (size_t)(r0 + q * nw) * 512 + h * 128 + 2 * lane) = pk2(a * rs * g0, b2 * rs * g1); }
    }
    bf16* P = (bf16*)(ows(A) + WS_P);
    int kglu = 384; asm volatile("" : "+s"(kglu));
    pg8::Gemm gm{P + PC_U, (const bf16*)(ows(A) + WS_WT + WT_GLU), kglu, PW}; RSched S; S.init(768, ogrid(), obid(), !ctx_out);
    EpiPair<1> E{P + PC_YD, PW, oin(A, 33) + L * 768, 384};
    pg8::gemm_phase<EpiPair<1>, RSched, true, true>((PG8_LAS unsigned char*)lds, gm, S, E);
}

struct MergeSched {
    RSched S; const bf16* XN; const bf16* WG; const bf16* WB; const bf16* P; const bf16* YB;
    __device__ __forceinline__ bool next(int j, pg8::Unit& u, pg8::Gemm& gm) const {
        if (!S.next(j >> 3, u)) return false;
        const int s8 = j & 7, i = ((s8 >> 2) << 1) | (s8 & 1), kind = (s8 >> 1) & 1, s = 2 * i + kind; u.aux = s;
        if ((s & 1) == 0) { gm.A = XN; gm.Bt = WG + (size_t)i * 1024 * 1024; gm.K = 1024; gm.lda = 1024; }
        else { gm.A = (i == 0) ? (P + PC_Z) : (i == 1) ? YB : (i == 2) ? (P + PC_GQ) : (P + PC_YD); gm.Bt = WB + (size_t)i * 1024 * 512; gm.K = (i == 3) ? 384 : 512; gm.lda = (i == 1) ? 512 : PW; }
        return true;
    }
};
__device__ __forceinline__ void phase_merge(const Args& A, int L, bool ctx_out, unsigned char* lds) {
    bf16* P = (bf16*)(ows(A) + WS_P);
    MergeSched MS; MS.S.init(1024, ogrid(), obid(), !ctx_out);
    MS.XN = (const bf16*)(ows(A) + WS_XN); MS.WG = (const bf16*)(ows(A) + WS_WT + WT_G); MS.WB = (const bf16*)(ows(A) + WS_WT + WT_BR); MS.P = P; MS.YB = (const bf16*)(ows(A) + WS_YB);
    EpiMerge E{(v4u*)(ows(A) + WS_MS + (size_t)obid() * 256 * KiB), (v4u*)(ows(A) + WS_GS + (size_t)obid() * 128 * KiB), P + PC_XM, PW, (const float*)(ows(A) + WS_SSQ)};
    pg8::gemm_phase_h<EpiMerge, MergeSched>((PG8_LAS unsigned char*)lds, MS, E);
}

#define GRID_SYNCW(bw, ord) grid_barrier((unsigned*)(A.ws + WS_XBAR))
#define GRID_SYNC(ord) GRID_SYNCW(0, ord)
#ifdef PROBE_LO
#define PROBE_LO_ PROBE_LO
#else
#define PROBE_LO_ 0
#endif
template <int KSEL, int L, int BW = 0> __device__ __forceinline__ void run_layer(const Args& A, unsigned char* lds, const int ph_lo, const int ph_hi) {
    constexpr bool ctx_out = (L == 0);
#define PH_BEGIN(k) if ((KSEL < 0 || KSEL == (k)) && ph_lo <= 1 + 12 * L + (k) && 1 + 12 * L + (k) < ph_hi) { \
        float* MOD = (float*)(ows(A) + WS_MOD); float* HC = (float*)(ows(A) + WS_HC); bf16* P = (bf16*)(ows(A) + WS_P); const bf16* XN = (const bf16*)(ows(A) + WS_XN); \
        const float* mod = MOD + (size_t)L * 5 * 6144; (void)HC; (void)P; (void)XN; (void)mod;
#define PH_END(k) if (1 + 12 * L + (k) + 1 < ph_hi) GRID_SYNCW(BW, BW == 0 ? 12 * L + (k) + 2 : (k) - PROBE_LO_ + 1); }
    PH_BEGIN(0) if (L != 0 || KSEL >= 0) phase_wconv(A, L, lds); phase_norm(A, L == 0 ? oin(A, 0) : oout(A), L == 0 ? oin(A, 2) : HC, oin(A, 6) + L * 1024, mod, 0, 1024, false); PH_END(0)
    PH_BEGIN(1) { pg8::Gemm gm{XN, (const bf16*)(ows(A) + WS_WT + WT_IN), 1024, 1024}; RSched S; S.init(4096, ogrid(), obid(), false); EpiStore E{P, PW};
        pg8::gemm_phase<EpiStore, RSched, true, true>((PG8_LAS unsigned char*)lds, gm, S, E); } PH_END(1)
    PH_BEGIN(2) phase_prep(A, L); PH_END(2)
    PH_BEGIN(3) phase_s1(A, L, lds); PH_END(3)
    PH_BEGIN(4) phase_s2(A, L); PH_END(4)
    PH_BEGIN(5) phase_s3(A, L, ctx_out, lds); PH_END(5)
    PH_BEGIN(6) phase_s4(A, L, ctx_out, lds); PH_END(6)
    PH_BEGIN(7) phase_merge(A, L, ctx_out, lds); PH_END(7)
    PH_BEGIN(8) { pg8::Gemm gm{P + PC_XM, (const bf16*)(ows(A) + WS_WT + WT_O), 1024, PW}; RSched S; S.init(1024, ogrid(), obid(), !ctx_out);
        EpiRes E{L == 0 ? oin(A, 0) : oout(A), L == 0 ? oin(A, 2) : HC, oout(A), HC, mod, 2048};
        pg8::gemm_phase<EpiRes, RSched, true, true>((PG8_LAS unsigned char*)lds, gm, S, E); } PH_END(8)
    PH_BEGIN(9) phase_norm(A, oout(A), HC, oin(A, 7) + L * 1024, mod, 3072, 4096, !ctx_out); PH_END(9)
    PH_BEGIN(10) { pg8::Gemm gm{XN, (const bf16*)(ows(A) + WS_WT + WT_GU), 1024, 1024}; RSched S; S.init(5632, ogrid(), obid(), !ctx_out);
        EpiPair<0> E{P, FFH, nullptr, 0};
        pg8::gemm_phase<EpiPair<0>, RSched, true, true>((PG8_LAS unsigned char*)lds, gm, S, E); } PH_END(10)
    PH_BEGIN(11) { pg8::Gemm gm{P, (const bf16*)(ows(A) + WS_WT + WT_DN), FFH, FFH}; RSched S; S.init(1024, ogrid(), obid(), !ctx_out);
        EpiRes E{oout(A), HC, oout(A), HC, mod, 5120};
        pg8::gemm_phase<EpiRes, RSched, true, true>((PG8_LAS unsigned char*)lds, gm, S, E); } PH_END(11)
#undef PH_BEGIN
#undef PH_END
}
template <int KSEL> __global__ void __launch_bounds__(NTHR, 2) hybrid_fwd(Args A) {
    extern __shared__ __attribute__((aligned(16))) unsigned char lds[];
    otid_init();
    if (KSEL < 0) { XcdBarrier b0 = xcd_barrier_post((unsigned*)(A.ws + WS_XBAR), (volatile unsigned*)(g_lds_ + LDS_XBST_OFF)); (void)b0; }
    if ((KSEL < 0 || KSEL == 12) && A.ph_lo == 0) { phase_mod(A, lds); if (KSEL < 0) { __syncthreads(); phase_wconv(A, 0, lds); } if (1 < A.ph_hi) GRID_SYNC(1); }
#ifdef PROBE_LO
    run_layer<KSEL, 0>(A, lds, A.ph_lo, 2 + PROBE_HI); GRID_SYNCW(2, 1);
    run_layer<KSEL, 0, 1>(A, lds, 1 + PROBE_LO, 2 + PROBE_HI); GRID_SYNCW(0, PROBE_HI + 2);
    run_layer<KSEL, 0>(A, lds, 2 + PROBE_HI, A.ph_hi);
#else
    run_layer<KSEL, 0>(A, lds, A.ph_lo, A.ph_hi);
#endif
    run_layer<KSEL, 1>(A, lds, A.ph_lo, A.ph_hi);
}

constexpr int N_PHASES = 25;
#ifndef MULTI_LAUNCH
#define MULTI_LAUNCH 0
#endif
template <int KSEL> static bool setup_kernel() {
    return hipFuncSetAttribute((const void*)hybrid_fwd<KSEL>, hipFuncAttributeMaxDynamicSharedMemorySize, LDS_TOTAL) == hipSuccess;
}
template <int KSEL> static void launch_phase(const Args& a, int grid, hipStream_t stream) { hipLaunchKernelGGL(hybrid_fwd<KSEL>, dim3(grid), dim3(NTHR), LDS_TOTAL, stream, a); }
extern "C" void kernel_launch(void* const* d_in, const int* in_sizes, int n_in, void* d_out, int out_size, void* d_ws, size_t ws_size, hipStream_t stream) {
    static int grid = 0;
    if (grid == 0) {
        if (n_in != 42 || ws_size < WS_NEED) { fprintf(stderr, "kernel_launch: unexpected n_in %d / ws %zu\n", n_in, ws_size); grid = -1; return; }
        int dev = 0, cus = 0;
        (void)hipGetDevice(&dev); (void)hipDeviceGetAttribute(&cus, hipDeviceAttributeMultiprocessorCount, dev);
#if MULTI_LAUNCH
        bool ok = setup_kernel<0>() && setup_kernel<1>() && setup_kernel<2>() && setup_kernel<3>() && setup_kernel<4>() && setup_kernel<5>() && setup_kernel<6>() && setup_kernel<7>() &&
                  setup_kernel<8>() && setup_kernel<9>() && setup_kernel<10>() && setup_kernel<11>() && setup_kernel<12>();
#else
        bool ok = setup_kernel<-1>();
#endif
        if (!ok) { fprintf(stderr, "kernel_launch: hipFuncSetAttribute failed\n"); grid = -1; return; }
        (void)hipGetLastError();
        grid = cus;
    }
    if (grid < 0) return;
    Args a{};
    for (int i = 0; i < 42; ++i) a.in[i] = (const float*)d_in[i];
    a.out = (float*)d_out; a.ws = (unsigned char*)d_ws;
#if MULTI_LAUNCH
    for (int ph = 0; ph < N_PHASES; ++ph) { a.ph_lo = ph; a.ph_hi = ph + 1;
        const int k = ph == 0 ? 12 : (ph - 1) % 12;
        switch (k) { case 0: launch_phase<0>(a, grid, stream); break; case 1: launch_phase<1>(a, grid, stream); break; case 2: launch_phase<2>(a, grid, stream); break;
            case 3: launch_phase<3>(a, grid, stream); break; case 4: launch_phase<4>(a, grid, stream); break; case 5: launch_phase<5>(a, grid, stream); break;
            case 6: launch_phase<6>(a, grid, stream); break; case 7: launch_phase<7>(a, grid, stream); break; case 8: launch_phase<8>(a, grid, stream); break;
            case 9: launch_phase<9>(a, grid, stream); break; case 10: launch_phase<10>(a, grid, stream); break; case 11: launch_phase<11>(a, grid, stream); break;
            default: launch_phase<12>(a, grid, stream); break; } }
#else
    a.ph_lo = 0; a.ph_hi = N_PHASES;
    (void)hipMemsetAsync((unsigned char*)d_ws + WS_XBAR, 0, 16384, stream);
    void* args[] = {&a};
    hipError_t e = hipLaunchCooperativeKernel((const void*)hybrid_fwd<-1>, dim3(grid), dim3(NTHR), args, LDS_TOTAL, stream);
    if (e != hipSuccess) fprintf(stderr, "cooperative launch failed: %s (grid %d)\n", hipGetErrorString(e), grid);
#endif
}
```

```cpp
#include <hip/hip_runtime.h>
#include <hip/hip_cooperative_groups.h>
#include <hip/hip_bf16.h>
#include <cstdio>
#include <cstdint>
#include <cmath>
namespace cg = cooperative_groups;
extern __shared__ __attribute__((aligned(16))) unsigned char g_lds_[];
constexpr int LDS_WTAB_OFF = 152 * 1024 - 16 - 256;
__device__ __forceinline__ unsigned hw_wave_key() { return (unsigned)__builtin_amdgcn_s_getreg(0x2804) & 63u; }
__device__ __forceinline__ void otid_init() { const int t = threadIdx.x; if ((t & 63) == 0) *(volatile int*)(g_lds_ + LDS_WTAB_OFF + hw_wave_key() * 4) = t >> 6;
    if (t < 4) *(volatile unsigned*)(g_lds_ + LDS_WTAB_OFF - 16 + t * 4) = 0u;
    __syncthreads(); }
__device__ __forceinline__ int otid() {
    const int wv = *(const volatile int*)(g_lds_ + LDS_WTAB_OFF + hw_wave_key() * 4);
    int t = wv * 64 + (int)__builtin_amdgcn_mbcnt_hi(~0u, __builtin_amdgcn_mbcnt_lo(~0u, 0u));
    asm volatile("" : "+v"(t)); return t;
}
namespace pg8 {
#define PG8_LAS __attribute__((address_space(3)))
typedef unsigned short bf16_t;
typedef short bf16x8 __attribute__((ext_vector_type(8)));
typedef float f32x4 __attribute__((ext_vector_type(4)));
typedef unsigned u32x4 __attribute__((ext_vector_type(4)));
constexpr int BM = 256, BK = 64, HALF = 128, HTB = HALF * BK * 2  , STAGE_BYTES = 8 * HTB, NXCD = 8, WGM = 8;

__host__ __device__ __forceinline__ int lds_byte(int r, int c) { const int st = (r >> 4) * 2 + (c >> 5), rr = r & 15, cc = c & 31, ob = rr * 64 + cc * 2; return st * 1024 + (ob ^ (((ob >> 9) & 1) << 5)); }
__host__ __device__ __forceinline__ void stage_rc(int b, int& R, int& C) { const int st = b / 1024, sb = b % 1024, swz = sb ^ (((sb >> 9) & 1) << 5); R = (st >> 1) * 16 + swz / 64; C = (st & 1) * 32 + (swz % 64) / 2; }
__host__ __device__ __forceinline__ int perm32(int rho) { const int n = rho >> 4, i = rho & 15; return 8 * (i >> 2) + 4 * n + (i & 3); }

struct Unit { int pm, pn, aux; };
struct Gemm { const bf16_t* A; const bf16_t* Bt; int K, lda; };

struct StaticOrder {
    int nM, nN, nwg, G, c;
    __host__ __device__ void init(int M, int N, int G_, int c_) { nM = M / BM; nN = N / BM; nwg = nM * nN; G = G_; c = c_; }
    __host__ __device__ bool next(int i, Unit& u) const {
        const long L = (long)i * G + c; if (L >= nwg) return false;
        int wgid = (int)L; { const int q = nwg / NXCD, r = nwg % NXCD, xcd = wgid % NXCD, off = wgid / NXCD; wgid = (xcd < r ? xcd * (q + 1) : r * (q + 1) + (xcd - r) * q) + off; }
        const int nig = WGM * nN, gid = wgid / nig, fm = gid * WGM, gsz = (nM - fm) < WGM ? (nM - fm) : WGM;
        u.pm = fm + ((wgid % nig) % gsz); u.pn = (wgid % nig) / gsz; return true;
    }
    __device__ __forceinline__ void a_ready(const Unit&) const {}
    __device__ __forceinline__ void done(const Unit&) const {}
};

__device__ __forceinline__ unsigned cvt_pk_bf16(float lo, float hi) { unsigned r; asm volatile("v_cvt_pk_bf16_f32 %0, %1, %2" : "=v"(r) : "v"(lo), "v"(hi)); return r; }
typedef float f32x2 __attribute__((ext_vector_type(2)));
__device__ __forceinline__ f32x2 gelu_pk(f32x2 v) {
    const f32x2 av = __builtin_elementwise_abs(v), d = av * 0.2316418882f + 1.0f;
    f32x2 t; t.x = __builtin_amdgcn_rcpf(d.x); t.y = __builtin_amdgcn_rcpf(d.y);
    f32x2 q = t * 0.5307027145f + (-0.7265760135f); q = q * t + 0.7107068705f; q = q * t + (-0.142248368f); q = q * t + 0.127414796f; q = q * t;
    const f32x2 s = (v * v) * (-0.72134752044f);
    f32x2 e; e.x = __builtin_amdgcn_exp2f(s.x); e.y = __builtin_amdgcn_exp2f(s.y);
    const f32x2 m = v * (q * e), r = v - m;
    f32x2 o; o.x = v.x < 0.f ? m.x : r.x; o.y = v.y < 0.f ? m.y : r.y; return o;
}

template <int ACT  > struct EpiBf16 {
    static constexpr bool PERM = true, AFTER_DRAIN = false, BIAS_INIT = false; static_assert(ACT == 0 || ACT == 1, "EpiBf16: ACT is 0 (none) or 1 (gelu_pk)");
    bf16_t* O; int ldc; const float* bias; int split_cols; size_t split_stride; float scale0;
    __device__ __forceinline__ void operator()(const f32x4 (&acc)[2][2][4][2], const Unit& u, int wr, int wc, int fr, int fq) const {
        const int row0 = u.pm * BM + wr * 64 + fr; int colt = u.pn * BM; bf16_t* base = O;
        float sc = 1.f; if (split_cols) { const int t = colt / split_cols; base += (size_t)t * split_stride; colt -= t * split_cols; if (t == 0) sc = scale0; }
        const int col0 = colt + wc * 32 + 8 * fq, bcol0 = u.pn * BM + wc * 32 + 8 * fq;
        f32x4 bv[2][2];
#pragma unroll
        for (int bj = 0; bj < 2; ++bj)
#pragma unroll
            for (int n = 0; n < 2; ++n) bv[bj][n] = bias ? *(const f32x4*)(bias + bcol0 + bj * HALF + 4 * n) : (f32x4){0.f, 0.f, 0.f, 0.f};
#pragma unroll
        for (int ai = 0; ai < 2; ++ai)
#pragma unroll
            for (int m = 0; m < 4; ++m) { bf16_t* rowp = base + (size_t)(row0 + ai * HALF + m * 16) * ldc + col0;
#pragma unroll
                for (int bj = 0; bj < 2; ++bj) { f32x4 v0 = acc[ai][bj][m][0] + bv[bj][0], v1 = acc[ai][bj][m][1] + bv[bj][1];
                    if (ACT == 1) { f32x2 a = gelu_pk((f32x2){v0[0], v0[1]}), b = gelu_pk((f32x2){v0[2], v0[3]}), c = gelu_pk((f32x2){v1[0], v1[1]}), d = gelu_pk((f32x2){v1[2], v1[3]});
                        v0 = (f32x4){a.x, a.y, b.x, b.y}; v1 = (f32x4){c.x, c.y, d.x, d.y}; }
                    v0 = v0 * sc; v1 = v1 * sc; u32x4 w; w.x = cvt_pk_bf16(v0[0], v0[1]); w.y = cvt_pk_bf16(v0[2], v0[3]); w.z = cvt_pk_bf16(v1[0], v1[1]); w.w = cvt_pk_bf16(v1[2], v1[3]);
                    *(u32x4*)(rowp + bj * HALF) = w; } }
    }
};
template <class Epi, class Sched, bool ALIGN_EPI = false, bool SP2 = false>
__device__ __forceinline__ void gemm_phase(PG8_LAS unsigned char* lds, const Gemm g, const Sched& S, const Epi& E) {
    const int tid = otid(), wid = __builtin_amdgcn_readfirstlane(tid >> 6), lane = tid & 63, wr = wid >> 2, wc = wid & 3, fr = lane & 15, fq = lane >> 4;
    const int K = g.K, nt = K / BK;
    unsigned voffA[2], voffB[2];
#pragma unroll
    for (int i = 0; i < 2; ++i) { int R, C; stage_rc(tid * 16 + i * 8192, R, C); const int Rb = Epi::PERM ? ((R & ~31) + perm32(R & 31)) : R;
        voffA[i] = (unsigned)(R * g.lda + C) * 2u; voffB[i] = (unsigned)(Rb * K + C) * 2u; }
    const size_t kstep = (size_t)(BK * 2);
    const size_t hstepA = (size_t)HALF * g.lda * 2, hstepB = (size_t)HALF * K * 2;
    const size_t tstepA = 2 * hstepA, tstepB = 2 * hstepB;
    const unsigned ldsw = (unsigned)wid * 1024u;
    const int aoff = lds_byte(wr * 64 + fr, fq * 8), boff = lds_byte(wc * 32 + fr, fq * 8);
#define PG8_SA(b, h) (((b) * 2 + (h)) * HTB)
#define PG8_SB(b, h) ((4 + (b) * 2 + (h)) * HTB)
#define PG8_STAGE(bufoff, gbase, voff) do { _Pragma("unroll") for (int _i = 0; _i < 2; ++_i) \
        __builtin_amdgcn_global_load_lds((const unsigned*)((const char*)(gbase) + (voff)[_i]), (PG8_LAS unsigned*)(lds + (bufoff) + ldsw + _i * 8192), 16, 0, 0); } while (0)
#define PG8_LDA(dst, b, h) do { _Pragma("unroll") for (int m = 0; m < 4; ++m) _Pragma("unroll") for (int k = 0; k < 2; ++k) dst[m][k] = *(const PG8_LAS bf16x8*)(lds + PG8_SA(b, h) + aoff + m * 2048 + k * 1024); } while (0)
#define PG8_LDB(dst, b, h) do { _Pragma("unroll") for (int n = 0; n < 2; ++n) _Pragma("unroll") for (int k = 0; k < 2; ++k) dst[n][k] = *(const PG8_LAS bf16x8*)(lds + PG8_SB(b, h) + boff + n * 2048 + k * 1024); } while (0)
#define PG8_MMA(ai, bj, At, Bt) do { __builtin_amdgcn_s_setprio(1); _Pragma("unroll") for (int m = 0; m < 4; ++m) _Pragma("unroll") for (int n = 0; n < 2; ++n) _Pragma("unroll") for (int k = 0; k < 2; ++k) \
        acc[ai][bj][m][n] = __builtin_amdgcn_mfma_f32_16x16x32_bf16(Bt[n][k], At[m][k], acc[ai][bj][m][n], 0, 0, 0); __builtin_amdgcn_s_setprio(0); } while (0)
#define PG8_WAIT_V(n) asm volatile("s_waitcnt vmcnt(" #n ")" ::: "memory")
#define PG8_WAIT_L(n) asm volatile("s_waitcnt lgkmcnt(" #n ")" ::: "memory")
#define PG8_BAR __builtin_amdgcn_s_barrier()
#define PG8_SCHED __builtin_amdgcn_sched_barrier(0)
    Unit cur, nxt; int ui = 0;
    if (!S.next(0, cur)) return;
    f32x4 acc[2][2][4][2];
#pragma unroll
    for (int a = 0; a < 2; ++a)
#pragma unroll
        for (int b = 0; b < 2; ++b)
#pragma unroll
            for (int m = 0; m < 4; ++m)
#pragma unroll
                for (int n = 0; n < 2; ++n) acc[a][b][m][n] = (f32x4){0.f, 0.f, 0.f, 0.f};
    if constexpr (Epi::BIAS_INIT) E.init(acc, cur, wc, fq);
    bf16x8 At[4][2], B0[2][2], B1[2][2];
    const char* cA = (const char*)g.A + (size_t)cur.pm * tstepA; const char* cB = (const char*)g.Bt + (size_t)cur.pn * tstepB;
    S.a_ready(cur);
    if constexpr (SP2) {
        PG8_STAGE(PG8_SB(0, 0), cB, voffB); PG8_STAGE(PG8_SB(0, 1), cB + hstepB, voffB); PG8_STAGE(PG8_SA(0, 0), cA, voffA); PG8_STAGE(PG8_SA(0, 1), cA + hstepA, voffA);
        if (wr == 1) PG8_BAR;
        PG8_WAIT_V(2); PG8_BAR;
        PG8_STAGE(PG8_SB(1, 0), cB + kstep, voffB); PG8_STAGE(PG8_SA(1, 0), cA + kstep, voffA); PG8_STAGE(PG8_SB(1, 1), cB + hstepB + kstep, voffB);
        PG8_WAIT_V(6); PG8_BAR;
    } else {
        PG8_STAGE(PG8_SB(0, 0), cB, voffB); PG8_STAGE(PG8_SA(0, 0), cA, voffA); PG8_STAGE(PG8_SB(0, 1), cB + hstepB, voffB); PG8_STAGE(PG8_SA(0, 1), cA + hstepA, voffA);
        if (wr == 1) PG8_BAR;
        PG8_WAIT_V(4); PG8_BAR;
        PG8_STAGE(PG8_SB(1, 0), cB + kstep, voffB); PG8_STAGE(PG8_SA(1, 0), cA + kstep, voffA); PG8_STAGE(PG8_SB(1, 1), cB + hstepB + kstep, voffB);
        PG8_WAIT_V(6); PG8_BAR;
    }
    for (;;) {
        const bool has_next = S.next(ui + 1, nxt);
        const char* nA = has_next ? (const char*)g.A + (size_t)nxt.pm * tstepA : cA; const char* nB = has_next ? (const char*)g.Bt + (size_t)nxt.pn * tstepB : cB;
        for (int t = 0; t < nt; t += 2) {
            const bool last = (t == nt - 2);
            const char* a1 = cA + (size_t)(t + 1) * kstep;
            const char* a2 = last ? nA : cA + (size_t)(t + 2) * kstep; const char* b2 = last ? nB : cB + (size_t)(t + 2) * kstep;
            const char* a3 = a2 + kstep; const char* b3 = b2 + kstep;
            if (last && has_next) S.a_ready(nxt);
            if constexpr (SP2) {
            PG8_LDB(B0, 0, 0); PG8_LDB(B1, 0, 1); PG8_SCHED; PG8_LDA(At, 0, 0); PG8_STAGE(PG8_SA(1, 1), a1 + hstepA, voffA);
            PG8_WAIT_V(8); PG8_WAIT_L(0); PG8_BAR; PG8_MMA(0, 0, At, B0); PG8_MMA(0, 1, At, B1); PG8_BAR; PG8_SCHED;
            PG8_LDA(At, 0, 1); PG8_STAGE(PG8_SB(0, 0), b2, voffB); PG8_STAGE(PG8_SB(0, 1), b2 + hstepB, voffB); PG8_STAGE(PG8_SA(0, 0), a2, voffA);
            PG8_WAIT_V(8); PG8_WAIT_L(0); PG8_BAR; PG8_MMA(1, 0, At, B0); PG8_MMA(1, 1, At, B1); PG8_BAR; PG8_SCHED;
            PG8_LDB(B0, 1, 0); PG8_LDB(B1, 1, 1); PG8_SCHED; PG8_LDA(At, 1, 0); PG8_STAGE(PG8_SA(0, 1), a2 + hstepA, voffA);
            PG8_WAIT_V(8); PG8_WAIT_L(0); PG8_BAR; PG8_MMA(0, 0, At, B0); PG8_MMA(0, 1, At, B1); PG8_BAR; PG8_SCHED;
            PG8_LDA(At, 1, 1); PG8_STAGE(PG8_SB(1, 0), b3, voffB); PG8_STAGE(PG8_SB(1, 1), b3 + hstepB, voffB); PG8_STAGE(PG8_SA(1, 0), a3, voffA);
            PG8_WAIT_V(8); PG8_WAIT_L(0); PG8_BAR; PG8_MMA(1, 0, At, B0); PG8_MMA(1, 1, At, B1); PG8_BAR; PG8_SCHED;
            } else {
            PG8_LDB(B0, 0, 0); PG8_SCHED; PG8_LDA(At, 0, 0); PG8_STAGE(PG8_SA(1, 1), a1 + hstepA, voffA);
            PG8_WAIT_L(8); PG8_BAR; PG8_WAIT_L(0); PG8_MMA(0, 0, At, B0); PG8_BAR; PG8_SCHED;
            PG8_LDB(B1, 0, 1); PG8_STAGE(PG8_SB(0, 0), b2, voffB);
            PG8_BAR; PG8_WAIT_L(0); PG8_MMA(0, 1, At, B1); PG8_BAR;
            PG8_LDA(At, 0, 1); PG8_STAGE(PG8_SA(0, 0), a2, voffA);
            PG8_BAR; PG8_WAIT_L(0); PG8_MMA(1, 0, At, B0); PG8_BAR; PG8_SCHED;
            PG8_STAGE(PG8_SB(0, 1), b2 + hstepB, voffB);
            PG8_WAIT_V(6); PG8_BAR; PG8_MMA(1, 1, At, B1); PG8_BAR;
            PG8_LDB(B0, 1, 0); PG8_SCHED; PG8_LDA(At, 1, 0); PG8_STAGE(PG8_SA(0, 1), a2 + hstepA, voffA);
            PG8_WAIT_L(8); PG8_BAR; PG8_WAIT_L(0); PG8_MMA(0, 0, At, B0); PG8_BAR; PG8_SCHED;
            PG8_LDB(B1, 1, 1); PG8_STAGE(PG8_SB(1, 0), b3, voffB);
            PG8_BAR; PG8_WAIT_L(0); PG8_MMA(0, 1, At, B1); PG8_BAR;
            PG8_LDA(At, 1, 1); PG8_STAGE(PG8_SA(1, 0), a3, voffA);
            PG8_BAR; PG8_WAIT_L(0); PG8_MMA(1, 0, At, B0); PG8_BAR; PG8_SCHED;
            PG8_STAGE(PG8_SB(1, 1), b3 + hstepB, voffB);
            PG8_WAIT_V(6); PG8_BAR; PG8_MMA(1, 1, At, B1); PG8_BAR;
            }
        }
        if constexpr (ALIGN_EPI) { if (wr == 0) PG8_BAR; }
        if constexpr (!Epi::AFTER_DRAIN) { E(acc, cur, wr, wc, fr, fq); S.done(cur); }
        if (!has_next) break;
#pragma unroll
        for (int a = 0; a < 2; ++a)
#pragma unroll
            for (int b = 0; b < 2; ++b)
#pragma unroll
                for (int m = 0; m < 4; ++m)
#pragma unroll
                    for (int n = 0; n < 2; ++n) acc[a][b][m][n] = (f32x4){0.f, 0.f, 0.f, 0.f};
        if constexpr (Epi::BIAS_INIT) E.init(acc, nxt, wc, fq);
        cur = nxt; cA = nA; cB = nB; ++ui;
        if constexpr (ALIGN_EPI) { if (wr == 1) PG8_BAR; }
    }
    PG8_WAIT_V(0);
    if constexpr (!ALIGN_EPI) { if (wr == 0) PG8_BAR; }
    PG8_BAR;
    if constexpr (Epi::AFTER_DRAIN) { E.fused(acc, cur, wr, wc, fr, fq, lds, wid, lane); S.done(cur); }
#undef PG8_SA
#undef PG8_SB
#undef PG8_STAGE
#undef PG8_LDA
#undef PG8_LDB
#undef PG8_MMA
#undef PG8_WAIT_V
#undef PG8_WAIT_L
#undef PG8_BAR
#undef PG8_SCHED
}

template <class Epi, class Sched>
__device__ __forceinline__ void gemm_phase_h(PG8_LAS unsigned char* lds, const Sched& S, const Epi& E) {
    const int tid = otid(), wid = __builtin_amdgcn_readfirstlane(tid >> 6), lane = tid & 63, wr = wid >> 2, wc = wid & 3, fr = lane & 15, fq = lane >> 4;
    int sR[2], sC[2], sRb[2];
#pragma unroll
    for (int i = 0; i < 2; ++i) { stage_rc(tid * 16 + i * 8192, sR[i], sC[i]); sRb[i] = Epi::PERM ? ((sR[i] & ~31) + perm32(sR[i] & 31)) : sR[i]; }
    Unit cur, nxt; Gemm gc, gn; int ui = 0;
    if (!S.next(0, cur, gc)) return;
    unsigned voffA[2], voffB[2], voffAn[2], voffBn[2];
#pragma unroll
    for (int i = 0; i < 2; ++i) { voffA[i] = (unsigned)(sR[i] * gc.lda + sC[i]) * 2u; voffB[i] = (unsigned)(sRb[i] * gc.K + sC[i]) * 2u; voffAn[i] = voffA[i]; voffBn[i] = voffB[i]; }
    const size_t kstep = (size_t)(BK * 2);
    size_t hstepA = (size_t)HALF * gc.lda * 2, hstepB = (size_t)HALF * gc.K * 2, hstepAn = hstepA, hstepBn = hstepB;
    int nt = gc.K / BK;
    const unsigned ldsw = (unsigned)wid * 1024u;
    const int aoff = lds_byte(wr * 64 + fr, fq * 8), boff = lds_byte(wc * 32 + fr, fq * 8);
#define PG8_SA(b, h) (((b) * 2 + (h)) * HTB)
#define PG8_SB(b, h) ((4 + (b) * 2 + (h)) * HTB)
#define PG8_STAGE(bufoff, gbase, voff) do { _Pragma("unroll") for (int _i = 0; _i < 2; ++_i) \
        __builtin_amdgcn_global_load_lds((const unsigned*)((const char*)(gbase) + (voff)[_i]), (PG8_LAS unsigned*)(lds + (bufoff) + ldsw + _i * 8192), 16, 0, 0); } while (0)
#define PG8_LDA(dst, b, h) do { _Pragma("unroll") for (int m = 0; m < 4; ++m) _Pragma("unroll") for (int k = 0; k < 2; ++k) dst[m][k] = *(const PG8_LAS bf16x8*)(lds + PG8_SA(b, h) + aoff + m * 2048 + k * 1024); } while (0)
#define PG8_LDB(dst, b, h) do { _Pragma("unroll") for (int n = 0; n < 2; ++n) _Pragma("unroll") for (int k = 0; k < 2; ++k) dst[n][k] = *(const PG8_LAS bf16x8*)(lds + PG8_SB(b, h) + boff + n * 2048 + k * 1024); } while (0)
#define PG8_MMA(ai, bj, At, Bt) do { __builtin_amdgcn_s_setprio(1); _Pragma("unroll") for (int m = 0; m < 4; ++m) _Pragma("unroll") for (int n = 0; n < 2; ++n) _Pragma("unroll") for (int k = 0; k < 2; ++k) \
        acc[ai][bj][m][n] = __builtin_amdgcn_mfma_f32_16x16x32_bf16(Bt[n][k], At[m][k], acc[ai][bj][m][n], 0, 0, 0); __builtin_amdgcn_s_setprio(0); } while (0)
#define PG8_WAIT_V(n) asm volatile("s_waitcnt vmcnt(" #n ")" ::: "memory")
#define PG8_WAIT_L(n) asm volatile("s_waitcnt lgkmcnt(" #n ")" ::: "memory")
#define PG8_BAR __builtin_amdgcn_s_barrier()
#define PG8_SCHED __builtin_amdgcn_sched_barrier(0)
    f32x4 acc[2][2][4][2];
#pragma unroll
    for (int a = 0; a < 2; ++a)
#pragma unroll
        for (int b = 0; b < 2; ++b)
#pragma unroll
            for (int m = 0; m < 4; ++m)
#pragma unroll
                for (int n = 0; n < 2; ++n) acc[a][b][m][n] = (f32x4){0.f, 0.f, 0.f, 0.f};
    bf16x8 At[4][2], B0[2][2], B1[2][2];
    const char* cA = (const char*)gc.A + (size_t)cur.pm * 2 * hstepA; const char* cB = (const char*)gc.Bt + (size_t)cur.pn * 2 * hstepB;
    PG8_STAGE(PG8_SB(0, 0), cB, voffB); PG8_STAGE(PG8_SB(0, 1), cB + hstepB, voffB); PG8_STAGE(PG8_SA(0, 0), cA, voffA); PG8_STAGE(PG8_SA(0, 1), cA + hstepA, voffA);
    if (wr == 1) PG8_BAR;
    PG8_WAIT_V(2); PG8_BAR;
    PG8_STAGE(PG8_SB(1, 0), cB + kstep, voffB); PG8_STAGE(PG8_SA(1, 0), cA + kstep, voffA); PG8_STAGE(PG8_SB(1, 1), cB + hstepB + kstep, voffB);
    PG8_WAIT_V(6); PG8_BAR;
    for (;;) {
        const bool has_next = S.next(ui + 1, nxt, gn);
        const char* nA = cA; const char* nB = cB;
        if (has_next) { hstepAn = (size_t)HALF * gn.lda * 2; hstepBn = (size_t)HALF * gn.K * 2;
#pragma unroll
            for (int i = 0; i < 2; ++i) { voffAn[i] = (unsigned)(sR[i] * gn.lda + sC[i]) * 2u; voffBn[i] = (unsigned)(sRb[i] * gn.K + sC[i]) * 2u; }
            nA = (const char*)gn.A + (size_t)nxt.pm * 2 * hstepAn; nB = (const char*)gn.Bt + (size_t)nxt.pn * 2 * hstepBn; }
        else { hstepAn = hstepA; hstepBn = hstepB;
#pragma unroll
            for (int i = 0; i < 2; ++i) { voffAn[i] = voffA[i]; voffBn[i] = voffB[i]; } }
        for (int t = 0; t < nt; t += 2) {
            const bool last = (t == nt - 2);
            const char* a1 = cA + (size_t)(t + 1) * kstep;
            const char* a2 = last ? nA : cA + (size_t)(t + 2) * kstep; const char* b2 = last ? nB : cB + (size_t)(t + 2) * kstep;
            const char* a3 = a2 + kstep; const char* b3 = b2 + kstep;
            const unsigned vA2[2] = {last ? voffAn[0] : voffA[0], last ? voffAn[1] : voffA[1]}, vB2[2] = {last ? voffBn[0] : voffB[0], last ? voffBn[1] : voffB[1]};
            const size_t hA2 = last ? hstepAn : hstepA, hB2 = last ? hstepBn : hstepB;
            PG8_LDB(B0, 0, 0); PG8_LDB(B1, 0, 1); PG8_SCHED; PG8_LDA(At, 0, 0); PG8_STAGE(PG8_SA(1, 1), a1 + hstepA, voffA);
            PG8_WAIT_V(8); PG8_WAIT_L(0); PG8_BAR; PG8_MMA(0, 0, At, B0); PG8_MMA(0, 1, At, B1); PG8_BAR; PG8_SCHED;
            PG8_LDA(At, 0, 1); PG8_STAGE(PG8_SB(0, 0), b2, vB2); PG8_STAGE(PG8_SB(0, 1), b2 + hB2, vB2); PG8_STAGE(PG8_SA(0, 0), a2, vA2);
            PG8_WAIT_V(8); PG8_WAIT_L(0); PG8_BAR; PG8_MMA(1, 0, At, B0); PG8_MMA(1, 1, At, B1); PG8_BAR; PG8_SCHED;
            PG8_LDB(B0, 1, 0); PG8_LDB(B1, 1, 1); PG8_SCHED; PG8_LDA(At, 1, 0); PG8_STAGE(PG8_SA(0, 1), a2 + hA2, vA2);
            PG8_WAIT_V(8); PG8_WAIT_L(0); PG8_BAR; PG8_MMA(0, 0, At, B0); PG8_MMA(0, 1, At, B1); PG8_BAR; PG8_SCHED;
            PG8_LDA(At, 1, 1); PG8_STAGE(PG8_SB(1, 0), b3, vB2); PG8_STAGE(PG8_SB(1, 1), b3 + hB2, vB2); PG8_STAGE(PG8_SA(1, 0), a3, vA2);
            PG8_WAIT_V(8); PG8_WAIT_L(0); PG8_BAR; PG8_MMA(1, 0, At, B0); PG8_MMA(1, 1, At, B1); PG8_BAR; PG8_SCHED;
        }
        E(acc, cur, wr, wc, fr, fq);
        if (!has_next) break;
#pragma unroll
        for (int a = 0; a < 2; ++a)
#pragma unroll
            for (int b = 0; b < 2; ++b)
#pragma unroll
                for (int m = 0; m < 4; ++m)
#pragma unroll
                    for (int n = 0; n < 2; ++n) acc[a][b][m][n] = (f32x4){0.f, 0.f, 0.f, 0.f};
        cur = nxt; gc = gn; cA = nA; cB = nB; hstepA = hstepAn; hstepB = hstepBn; nt = gc.K / BK; ++ui;
#pragma unroll
        for (int i = 0; i < 2; ++i) { voffA[i] = voffAn[i]; voffB[i] = voffBn[i]; }
    }
    PG8_WAIT_V(0);
    if (wr == 0) PG8_BAR;
    PG8_BAR;
#undef PG8_SA
#undef PG8_SB
#undef PG8_STAGE
#undef PG8_LDA
#undef PG8_LDB
#undef PG8_MMA
#undef PG8_WAIT_V
#undef PG8_WAIT_L
#undef PG8_BAR
#undef PG8_SCHED
}
}

#ifndef PG8_SP2
#define PG8_SP2 true
#endif
#include <hip/hip_bf16.h>
#include <cmath>
namespace attn_body {
using bf16=__hip_bfloat16;
using bf16x8=__attribute__((ext_vector_type(8)))short;
using s16x4=__attribute__((ext_vector_type(4)))short;
using f32x16=__attribute__((ext_vector_type(16)))float;
using u32x4=__attribute__((ext_vector_type(4)))unsigned;
constexpr int D=64,DM=4096;
constexpr int NW=8,QBLK=32,QB=QBLK*NW,KVBLK=64;
__device__ __forceinline__ int crow(int r,int hi){return (r&3)+8*(r>>2)+4*hi;}
#define SBAR() __builtin_amdgcn_sched_barrier(0)
__device__ __forceinline__ void cmask(f32x16&p0,f32x16&p1,int jb,int qrel,int hi){
  const float NEG=-INFINITY; int kb=64*jb+4*hi;
  #pragma unroll
  for(int r=0;r<16;++r){int kv=kb+(r&3)+8*(r>>2); if(kv>qrel)p0[r]=NEG; if(kv+32>qrel)p1[r]=NEG;}
}

constexpr int NSLOT=3, SLOTB=8192;
constexpr int LDS_K=0, LDS_V=NSLOT*SLOTB, LDS_WS=3*NSLOT*SLOTB, LDS_OST=LDS_WS+NW*64*4, LDS_BYTES=LDS_OST+NW*4096;
constexpr float C2=0.125f*1.4426950408889634f;
__device__ __forceinline__ void glds16(const void*gsrc,unsigned lds_dst){unsigned keep;
  asm volatile("s_mov_b32 %0, m0\n\ts_mov_b32 m0, %2\n\ts_nop 0\n\tglobal_load_lds_dwordx4 %1, off\n\ts_mov_b32 m0, %0":"=&s"(keep):"v"(gsrc),"s"(lds_dst):"memory");}
__device__ __forceinline__ float max3f(float a,float b,float c){float r;asm("v_max3_f32 %0, %1, %2, %3":"=v"(r):"v"(a),"v"(b),"v"(c));return r;}
__device__ __forceinline__ float max2f(float a,float b){float r;asm("v_max_f32_e32 %0, %1, %2":"=v"(r):"v"(a),"v"(b));return r;}
__device__ __forceinline__ float fadd_s(float a,float b){float r;asm("v_add_f32_e32 %0, %1, %2":"=v"(r):"v"(a),"v"(b));return r;}
__device__ __forceinline__ float fsub_s(float a,float b){float r;asm("v_sub_f32_e32 %0, %1, %2":"=v"(r):"v"(a),"v"(b));return r;}
typedef float f32x2_t __attribute__((ext_vector_type(2))); typedef __bf16 bf16x2_t __attribute__((ext_vector_type(2)));
__device__ __forceinline__ unsigned cvtpk_s(float lo,float hi){f32x2_t v={lo,hi};bf16x2_t b=__builtin_convertvector(v,bf16x2_t);return __builtin_bit_cast(unsigned,b);}
#define WAIT_BAR(N) asm volatile("s_waitcnt vmcnt(" #N ") lgkmcnt(0)\n\ts_barrier":::"memory")

__device__ __forceinline__ void qkt(f32x16&p0,f32x16&p1,const char*Kslot,const bf16x8*qr,const f32x16&negm,int r32,int hi){
  const char*kb=Kslot+hi*1024+r32*16;
  #pragma unroll
  for(int d0=0;d0<4;++d0){
    const bf16x8 b0=*reinterpret_cast<const bf16x8*>(kb+d0*2048);
    const bf16x8 b1=*reinterpret_cast<const bf16x8*>(kb+d0*2048+512);
    if(d0==0){p0=__builtin_amdgcn_mfma_f32_32x32x16_bf16(b0,qr[0],negm,0,0,0);p1=__builtin_amdgcn_mfma_f32_32x32x16_bf16(b1,qr[0],negm,0,0,0);}
    else{p0=__builtin_amdgcn_mfma_f32_32x32x16_bf16(b0,qr[d0],p0,0,0,0);p1=__builtin_amdgcn_mfma_f32_32x32x16_bf16(b1,qr[d0],p1,0,0,0);}}
}
typedef __attribute__((address_space(3))) const char* lds_cptr;
typedef short v4i16_t __attribute__((ext_vector_type(4)));
__device__ __forceinline__ void kload8(bf16x8*kf,lds_cptr kp){
  kf[0]=*(const __attribute__((address_space(3))) bf16x8*)(kp);      kf[1]=*(const __attribute__((address_space(3))) bf16x8*)(kp+512);
  kf[2]=*(const __attribute__((address_space(3))) bf16x8*)(kp+2048); kf[3]=*(const __attribute__((address_space(3))) bf16x8*)(kp+2560);
  kf[4]=*(const __attribute__((address_space(3))) bf16x8*)(kp+4096); kf[5]=*(const __attribute__((address_space(3))) bf16x8*)(kp+4608);
  kf[6]=*(const __attribute__((address_space(3))) bf16x8*)(kp+6144); kf[7]=*(const __attribute__((address_space(3))) bf16x8*)(kp+6656);
}
__device__ __forceinline__ void kload2(bf16x8*kf,lds_cptr kp,int j){ kf[2*j]=*(const __attribute__((address_space(3))) bf16x8*)(kp+j*2048); kf[2*j+1]=*(const __attribute__((address_space(3))) bf16x8*)(kp+j*2048+512); }
__device__ __forceinline__ s16x4 vtr(lds_cptr p){ return __builtin_bit_cast(s16x4,__builtin_amdgcn_ds_read_tr16_b64_v4i16((__attribute__((address_space(3))) v4i16_t*)p)); }
__device__ __forceinline__ float rowmax(const f32x16&p0,const f32x16&p1){
  float a=max3f(p0[0],p0[1],p1[0]),b=max3f(p0[2],p0[3],p1[1]);a=max3f(a,p1[2],p1[3]);
  #pragma unroll
  for(int r=4;r<16;r+=4){a=max3f(a,p0[r],p0[r+1]);b=max3f(b,p0[r+2],p0[r+3]);a=max3f(a,p1[r],p1[r+1]);b=max3f(b,p1[r+2],p1[r+3]);}
  const float m=max2f(a,b);
  auto rr=__builtin_amdgcn_permlane32_swap(__float_as_uint(m),__float_as_uint(m),false,false);
  return max2f(__uint_as_float(rr[0]),__uint_as_float(rr[1]));
}
__device__ __forceinline__ void pv(f32x16*o,int vb,bf16x8 pa0,bf16x8 pa1,bf16x8 pa2,bf16x8 pa3){
  #pragma unroll
  for(int d0=0;d0<2;++d0){s16x4 lo[4],hi[4];
    #pragma unroll
    for(int ks=0;ks<4;++ks){
      asm volatile("ds_read_b64_tr_b16 %0,%1 offset:%c2":"=&v"(lo[ks]):"v"(vb),"i"(d0*4096+ks*1024):"memory");
      asm volatile("ds_read_b64_tr_b16 %0,%1 offset:%c2":"=&v"(hi[ks]):"v"(vb),"i"(d0*4096+ks*1024+512):"memory");}
    asm volatile("s_waitcnt lgkmcnt(0)":::"memory");SBAR();
    #define PK(k) (bf16x8){lo[k][0],lo[k][1],lo[k][2],lo[k][3],hi[k][0],hi[k][1],hi[k][2],hi[k][3]}
    o[d0]=__builtin_amdgcn_mfma_f32_32x32x16_bf16(pa0,PK(0),o[d0],0,0,0);
    o[d0]=__builtin_amdgcn_mfma_f32_32x32x16_bf16(pa1,PK(1),o[d0],0,0,0);
    o[d0]=__builtin_amdgcn_mfma_f32_32x32x16_bf16(pa2,PK(2),o[d0],0,0,0);
    o[d0]=__builtin_amdgcn_mfma_f32_32x32x16_bf16(pa3,PK(3),o[d0],0,0,0);
    #undef PK
  }
}

#ifndef ATTN_STORE16
#define ATTN_STORE16(p,v) (*(u32x4*)(p)=(v))
#endif
template<int THRL,int VH> __device__ __forceinline__ void attn_unit(const int MODE,const bf16*Qp,const bf16*__restrict__ Kp,const bf16*__restrict__ Vp,bf16*Op,const int opitch,const int NT,const float lam,char*shm){
  const int tid=otid(),lane=tid&63,r32=lane&31,hi=lane>>5; const int wid=__builtin_amdgcn_readfirstlane(tid>>6);
  const bf16*Qw=Qp+(long)(wid*QBLK)*DM;
  const bf16*Kh=Kp,*Vh=Vp;
  const unsigned lds0=(unsigned)(uintptr_t)shm;
  float*wsf=(float*)(shm+LDS_WS)+wid*64;
  const bf16*ksrc=Kh+(long)lane*DM+wid*8;
  const bf16*vsrc=Vh+(long)(16*(wid&3)+(lane>>2))*DM+(wid>>2)*32+(lane&3)*8;
  const unsigned kdst=lds0+LDS_K+wid*1024, vdst=lds0+LDS_V+wid*1024;
  #define DMA_K(t,slot) glds16(ksrc+(long)(t)*KVBLK*DM,(unsigned)__builtin_amdgcn_readfirstlane(kdst+(slot)))
  #define DMA_V(t,slot) do{ glds16(vsrc+(long)(t)*KVBLK*DM,(unsigned)__builtin_amdgcn_readfirstlane(vdst+2*(slot))); if(VH==2) glds16(vsrc+(long)(t)*KVBLK*DM+64,(unsigned)__builtin_amdgcn_readfirstlane(vdst+2*(slot)+8192)); }while(0)
  #define WAITB(N1,N2) do{ if(VH==2){WAIT_BAR(N2);}else{WAIT_BAR(N1);} }while(0)
  const int vb0=(int)(lds0+LDS_V)+((lane>>4)&1)*32+(lane&3)*8+(4*hi+((lane&15)>>2))*64;
  const char*Kbase=shm+LDS_K; bf16x8 kf[8];
  const lds_cptr shm3=(lds_cptr)shm; const lds_cptr kp0=shm3+LDS_K+hi*1024+r32*16; const lds_cptr vp0=shm3+LDS_V+((lane>>4)&1)*32+(lane&3)*8+(4*hi+((lane&15)>>2))*64;
  DMA_K(0,0);DMA_V(0,0);DMA_K(1,SLOTB);
  bf16x8 qr[4];
  #pragma unroll
  for(int d0=0;d0<4;++d0)qr[d0]=*reinterpret_cast<const bf16x8*>(&Qw[(long)r32*DM+d0*16+hi*8]);
  float mhat=0.f,l_reg=0.f;f32x16 o[2*VH]; _Pragma("unroll") for(int d_=0;d_<2*VH;++d_)o[d_]=f32x16{};f32x16 negm=f32x16{}; if(VH==1) asm volatile("":"+v"(negm)); const f32x16 zero16_=f32x16{};
  #define CMASK(P0,P1,t) do{}while(0)
  bool resc=false;
  #define START(P0,P1) do{ const float rm=rowmax(P0,P1); resc=false; \
    { const float dl=(VH==2)?((rm>(float)THRL)?rm:0.f):rm;   mhat=fadd_s(mhat,dl); \
      _Pragma("unroll") for(int r=0;r<16;++r){P0[r]=fsub_s(P0[r],dl);P1[r]=fsub_s(P1[r],dl);} \
      if(VH==1){ _Pragma("unroll") for(int r=0;r<16;++r)negm[r]=-mhat; asm volatile("":"+v"(negm)); } } \
    _Pragma("unroll") for(int r=0;r<16;++r)P0[r]=__builtin_amdgcn_exp2f(P0[r]); }while(0)
  #define RESC() do{ if(resc){ asm volatile("s_waitcnt lgkmcnt(0)":::"memory"); \
      _Pragma("unroll") for(int d_=0;d_<2*VH;++d_) _Pragma("unroll") for(int r=0;r<16;++r)o[d_][r]*=wsf[crow(r,hi)]; } }while(0)
  f32x16 pA0,pA1,pB0,pB1;
  int sl_prev=0,sl_cur=0,sl_next=SLOTB;
  #define ROT() do{sl_prev=sl_cur;sl_cur=sl_next;sl_next=(sl_next==(NSLOT-1)*SLOTB)?0:sl_next+SLOTB;}while(0)
  DMA_K(2,2*SLOTB);
  WAITB(3,4);
  qkt(pA0,pA1,Kbase,qr,negm,r32,hi);asm volatile("s_nop 15\n\ts_nop 7":"+v"(pA0),"+v"(pA1));CMASK(pA0,pA1,0);
  START(pA0,pA1);
  _Pragma("unroll") for(int r=0;r<16;++r)pA1[r]=__builtin_amdgcn_exp2f(pA1[r]);
  WAIT_BAR(0);
  DMA_K(3,0);DMA_V(1,SLOTB);
  ROT();
  kload8(kf,kp0+sl_cur);
  WAITB(2,3);
  s16x4 vlo[8],vhi[8]; u32x4 pw0,pw1,pw2,pw3;
  #define PKW(P,B) cvtpk_s(P[B],P[B+1])
  #define PAF(k) __builtin_bit_cast(bf16x8,pw##k)
  #define VFR(i) (bf16x8){vlo[i][0],vlo[i][1],vlo[i][2],vlo[i][3],vhi[i][0],vhi[i][1],vhi[i][2],vhi[i][3]}
  #define PIN(x) asm volatile("":"+v"(x))
  #define MX3(a,b,c) __builtin_fmaxf(__builtin_fmaxf((a),(b)),(c))
  #define GAPA(MF,A0,A1,A2,A3,W0,W1,PW) do{ MF; sacc+=A0; sacc+=A1; sacc+=A2; sacc+=A3; PIN(sacc); W0; W1; PIN(PW); SBAR(); }while(0)
  #define EX(v) __builtin_amdgcn_exp2f(v)
  #define GAPB(MF,X,B) do{ MF; X[B]=EX(X[B]); X[B+1]=EX(X[B+1]); X[B+2]=EX(X[B+2]); X[B+3]=EX(X[B+3]); PIN(X); SBAR(); }while(0)
  #define GAPB2(MF,X,B) do{ MF; X[B]=EX(X[B]); X[B+1]=EX(X[B+1]); PIN(X); SBAR(); }while(0)
  #define VRD(i) do{ vlo[i]=vtr(vp_+(((i)>>2)*4096+((i)&3)*1024)); vhi[i]=vtr(vp_+(((i)>>2)*4096+((i)&3)*1024+512)); }while(0)
  #define KRD(G,j) do{ if(G){ kload2(kf,kp0+sl_next,j); SBAR(); } }while(0)
  #define V2RD(i) do{ if(VH==2){ vlo[i]=vtr(vp_+8192+(((i)>>2)*4096+((i)&3)*1024)); vhi[i]=vtr(vp_+8192+(((i)>>2)*4096+((i)&3)*1024+512)); SBAR(); } }while(0)
  #define STEP(C0,C1,P0,P1,t,GK,GV,GL) do{ SBAR(); \
    const lds_cptr vp_=vp0+2*sl_prev; \
    VRD(0); SBAR(); float sacc=(P0[0]+P0[1]); \
    GAPA(C0=__builtin_amdgcn_mfma_f32_32x32x16_bf16(kf[0],qr[0],(VH==1?negm:zero16_),0,0,0), P0[2],P0[3],P0[4],P0[5],     pw0[0]=PKW(P0,0), pw0[1]=PKW(P0,2), pw0); \
    VRD(4); SBAR(); GAPA(C1=__builtin_amdgcn_mfma_f32_32x32x16_bf16(kf[1],qr[0],(VH==1?negm:zero16_),0,0,0), P0[6],P0[7],P0[8],P0[9],     pw0[2]=PKW(P0,4), pw0[3]=PKW(P0,6), pw0); \
    VRD(1); SBAR(); GAPA(C0=__builtin_amdgcn_mfma_f32_32x32x16_bf16(kf[2],qr[1],C0,0,0,0),   P0[10],P0[11],P0[12],P0[13], pw1[0]=PKW(P0,8), pw1[1]=PKW(P0,10), pw1); \
    VRD(5); SBAR(); GAPA(C1=__builtin_amdgcn_mfma_f32_32x32x16_bf16(kf[3],qr[1],C1,0,0,0),   P0[14],P0[15],P1[0],P1[1],   pw1[2]=PKW(P0,12),pw1[3]=PKW(P0,14), pw1); \
    VRD(2); SBAR(); GAPA(C0=__builtin_amdgcn_mfma_f32_32x32x16_bf16(kf[4],qr[2],C0,0,0,0),   P1[2],P1[3],P1[4],P1[5],     pw2[0]=PKW(P1,0), pw2[1]=PKW(P1,2), pw2); \
    VRD(6); SBAR(); GAPA(C1=__builtin_amdgcn_mfma_f32_32x32x16_bf16(kf[5],qr[2],C1,0,0,0),   P1[6],P1[7],P1[8],P1[9],     pw2[2]=PKW(P1,4), pw2[3]=PKW(P1,6), pw2); \
    VRD(3); SBAR(); GAPA(C0=__builtin_amdgcn_mfma_f32_32x32x16_bf16(kf[6],qr[3],C0,0,0,0),   P1[10],P1[11],P1[12],P1[13], pw3[0]=PKW(P1,8), pw3[1]=PKW(P1,10), pw3); \
    VRD(7); SBAR(); GAPA(C1=__builtin_amdgcn_mfma_f32_32x32x16_bf16(kf[7],qr[3],C1,0,0,0),   P1[14],P1[15],0.f,0.f,       pw3[2]=PKW(P1,12),pw3[3]=PKW(P1,14), pw3); \
    l_reg+=sacc; \
    if(GK){DMA_K((t)+3,sl_cur);} if(GV){DMA_V((t)+1,sl_next);} \
    CMASK(C0,C1,t); \
    if(VH==2){ if(__builtin_expect(__any(mhat!=0.f),0)){ _Pragma("unroll") for(int r=0;r<16;++r){C0[r]-=mhat;C1[r]-=mhat;} } } \
    { float a=MX3(C0[0],C0[1],C1[0]),b=MX3(C0[2],C0[3],C1[1]); a=MX3(a,C1[2],C1[3]); \
      _Pragma("unroll") for(int r=4;r<16;r+=4){a=MX3(a,C0[r],C0[r+1]);b=MX3(b,C0[r+2],C0[r+3]);a=MX3(a,C1[r],C1[r+1]);b=MX3(b,C1[r+2],C1[r+3]);} \
      float rm=__builtin_fmaxf(a,b); { auto rr=__builtin_amdgcn_permlane32_swap(__float_as_uint(rm),__float_as_uint(rm),false,false); rm=__builtin_fmaxf(__uint_as_float(rr[0]),__uint_as_float(rr[1])); } \
      resc=false; \
      if(__builtin_expect(__any(rm>(float)THRL),0)){ const float dl=__builtin_fmaxf(rm,0.f); mhat+=dl; \
        _Pragma("unroll") for(int r=0;r<16;++r){C0[r]-=dl;C1[r]-=dl;} \
        if(VH==1){ _Pragma("unroll") for(int r=0;r<16;++r)negm[r]=-mhat; asm volatile("":"+v"(negm)); } \
        const float f=__builtin_amdgcn_exp2f(-dl); l_reg*=f; if(hi==0)wsf[r32]=f; resc=true; } } \
    SBAR(); \
    if(VH==1){ \
    GAPB(o[0]=__builtin_amdgcn_mfma_f32_32x32x16_bf16(PAF(0),VFR(0),o[0],0,0,0), C0,0); \
    GAPB(o[1]=__builtin_amdgcn_mfma_f32_32x32x16_bf16(PAF(0),VFR(4),o[1],0,0,0), C0,4); \
    KRD(GL,0); GAPB(o[0]=__builtin_amdgcn_mfma_f32_32x32x16_bf16(PAF(1),VFR(1),o[0],0,0,0), C0,8); \
    KRD(GL,1); GAPB(o[1]=__builtin_amdgcn_mfma_f32_32x32x16_bf16(PAF(1),VFR(5),o[1],0,0,0), C0,12); \
    KRD(GL,2); GAPB(o[0]=__builtin_amdgcn_mfma_f32_32x32x16_bf16(PAF(2),VFR(2),o[0],0,0,0), C1,0); \
    KRD(GL,3); GAPB(o[1]=__builtin_amdgcn_mfma_f32_32x32x16_bf16(PAF(2),VFR(6),o[1],0,0,0), C1,4); \
    GAPB(o[0]=__builtin_amdgcn_mfma_f32_32x32x16_bf16(PAF(3),VFR(3),o[0],0,0,0), C1,8); \
    GAPB(o[1]=__builtin_amdgcn_mfma_f32_32x32x16_bf16(PAF(3),VFR(7),o[1],0,0,0), C1,12); \
    } else {   \
    GAPB2(o[0]=__builtin_amdgcn_mfma_f32_32x32x16_bf16(PAF(0),VFR(0),o[0],0,0,0), C0,0); V2RD(0); \
    GAPB2(o[1]=__builtin_amdgcn_mfma_f32_32x32x16_bf16(PAF(0),VFR(4),o[1],0,0,0), C0,2); V2RD(4); \
    KRD(GL,0); GAPB2(o[0]=__builtin_amdgcn_mfma_f32_32x32x16_bf16(PAF(1),VFR(1),o[0],0,0,0), C0,4); V2RD(1); \
    KRD(GL,1); GAPB2(o[1]=__builtin_amdgcn_mfma_f32_32x32x16_bf16(PAF(1),VFR(5),o[1],0,0,0), C0,6); V2RD(5); \
    KRD(GL,2); GAPB2(o[0]=__builtin_amdgcn_mfma_f32_32x32x16_bf16(PAF(2),VFR(2),o[0],0,0,0), C0,8); V2RD(2); \
    KRD(GL,3); GAPB2(o[1]=__builtin_amdgcn_mfma_f32_32x32x16_bf16(PAF(2),VFR(6),o[1],0,0,0), C0,10); V2RD(6); \
    GAPB2(o[0]=__builtin_amdgcn_mfma_f32_32x32x16_bf16(PAF(3),VFR(3),o[0],0,0,0), C0,12); V2RD(3); \
    GAPB2(o[1]=__builtin_amdgcn_mfma_f32_32x32x16_bf16(PAF(3),VFR(7),o[1],0,0,0), C0,14); V2RD(7); \
    GAPB2(o[2*VH-2]=__builtin_amdgcn_mfma_f32_32x32x16_bf16(PAF(0),VFR(0),o[2*VH-2],0,0,0), C1,0); \
    GAPB2(o[2*VH-1]=__builtin_amdgcn_mfma_f32_32x32x16_bf16(PAF(0),VFR(4),o[2*VH-1],0,0,0), C1,2); \
    GAPB2(o[2*VH-2]=__builtin_amdgcn_mfma_f32_32x32x16_bf16(PAF(1),VFR(1),o[2*VH-2],0,0,0), C1,4); \
    GAPB2(o[2*VH-1]=__builtin_amdgcn_mfma_f32_32x32x16_bf16(PAF(1),VFR(5),o[2*VH-1],0,0,0), C1,6); \
    GAPB2(o[2*VH-2]=__builtin_amdgcn_mfma_f32_32x32x16_bf16(PAF(2),VFR(2),o[2*VH-2],0,0,0), C1,8); \
    GAPB2(o[2*VH-1]=__builtin_amdgcn_mfma_f32_32x32x16_bf16(PAF(2),VFR(6),o[2*VH-1],0,0,0), C1,10); \
    GAPB2(o[2*VH-2]=__builtin_amdgcn_mfma_f32_32x32x16_bf16(PAF(3),VFR(3),o[2*VH-2],0,0,0), C1,12); \
    GAPB2(o[2*VH-1]=__builtin_amdgcn_mfma_f32_32x32x16_bf16(PAF(3),VFR(7),o[2*VH-1],0,0,0), C1,14); \
    } \
    }while(0)
  int t=1;
  #undef CMASK
  #define CMASK(P0,P1,t) do{}while(0)
  for(;t+5<NT;t+=2){
    STEP(pB0,pB1,pA0,pA1,t,true,true,true);     WAITB(2,3); RESC(); ROT();
    STEP(pA0,pA1,pB0,pB1,t+1,true,true,true);   WAITB(2,3); RESC(); ROT();
  }
  #undef CMASK
  #define CMASK(P0,P1,t) do{}while(0)
  #define ENDW(tt) do{ if((tt)+3<NT){WAITB(2,3);} else if((tt)+2<NT){WAITB(1,2);} else {WAIT_BAR(0);} }while(0)
  for(;t+1<NT;t+=2){
    STEP(pB0,pB1,pA0,pA1,t,(t+3<NT),(t+1<NT),(t+1<NT));       ENDW(t);   RESC(); ROT();
    STEP(pA0,pA1,pB0,pB1,t+1,(t+4<NT),(t+2<NT),(t+2<NT));     ENDW(t+1); RESC(); ROT();
  }
  STEP(pB0,pB1,pA0,pA1,NT-1,false,false,false); RESC();
  { float sacc=pB0[0]+pB0[1]; _Pragma("unroll") for(int r=2;r<16;++r)sacc+=pB0[r]; _Pragma("unroll") for(int r=0;r<16;++r)sacc+=pB1[r]; l_reg+=sacc;
    pw0=(u32x4){PKW(pB0,0),PKW(pB0,2),PKW(pB0,4),PKW(pB0,6)};pw1=(u32x4){PKW(pB0,8),PKW(pB0,10),PKW(pB0,12),PKW(pB0,14)};pw2=(u32x4){PKW(pB1,0),PKW(pB1,2),PKW(pB1,4),PKW(pB1,6)};pw3=(u32x4){PKW(pB1,8),PKW(pB1,10),PKW(pB1,12),PKW(pB1,14)};
    SBAR(); pv(o,vb0+2*sl_cur,PAF(0),PAF(1),PAF(2),PAF(3)); if(VH==2) pv(o+2,vb0+2*sl_cur+8192,PAF(0),PAF(1),PAF(2),PAF(3)); }
  #undef PKW
  #undef PAF
  #undef VFR
  #undef PIN
  #undef MX3
  #undef GAPA
  #undef GAPB
  #undef GAPB2
  #undef EX
  #undef VRD
  #undef KRD
  #undef V2RD
  #undef STEP
  #undef ENDW
  {auto rr=__builtin_amdgcn_permlane32_swap(__float_as_uint(l_reg),__float_as_uint(l_reg),false,false);l_reg=__uint_as_float(rr[0])+__uint_as_float(rr[1]);}
  if(hi==0)wsf[32+r32]=l_reg;asm volatile("s_waitcnt lgkmcnt(0)":::"memory");
  float rli[16];
  #pragma unroll
  for(int r=0;r<16;++r)rli[r]=__builtin_amdgcn_rcpf(wsf[32+crow(r,hi)]);
  bf16*Ow=Op+(long)(wid*QBLK)*opitch;
  { bf16*stg=(bf16*)(shm+LDS_OST)+wid*2048;
    #pragma unroll
    for(int hf=0;hf<VH;++hf){
    #pragma unroll
    for(int r=0;r<16;++r){const int orow=crow(r,hi);
      #pragma unroll
      for(int d0=0;d0<2;++d0)stg[orow*64+d0*32+r32]=__float2bfloat16(o[hf*2+d0][r]*rli[r]);}
    asm volatile("s_waitcnt lgkmcnt(0)":::"memory");
    #pragma unroll
    for(int i=0;i<4;++i){const int row=i*8+(lane>>3),ch=lane&7; u32x4 v=*(const u32x4*)(stg+row*64+ch*8); bf16*dst=Ow+(long)row*opitch+hf*64+ch*8;
      if(MODE==2){ const u32x4 old=*(const u32x4*)dst;
        #pragma unroll
        for(int e=0;e<4;++e){ const float a0=__uint_as_float(old[e]<<16)-lam*__uint_as_float(v[e]<<16), a1=__uint_as_float(old[e]&0xffff0000u)-lam*__uint_as_float(v[e]&0xffff0000u); v[e]=cvtpk_s(a0,a1); } }
      ATTN_STORE16(dst,v);}
    asm volatile("s_waitcnt lgkmcnt(0)":::"memory");
    } }
  asm volatile("s_waitcnt lgkmcnt(0)\n\ts_barrier":::"memory");
  #undef DMA_K
  #undef DMA_V
  #undef WAITB
  #undef CMASK
  #undef START
  #undef RESC
  #undef ROT
}
constexpr int ATTN_LDS_BYTES=LDS_BYTES;
#undef SBAR
#undef WAIT_BAR
}

typedef unsigned short bf16;
typedef unsigned v4u __attribute__((ext_vector_type(4)));
typedef unsigned v2u __attribute__((ext_vector_type(2)));
typedef float f32x4 __attribute__((ext_vector_type(4)));
typedef float f32x2 __attribute__((ext_vector_type(2)));
typedef short bf16x8 __attribute__((ext_vector_type(8)));

constexpr int NB = 4, SEQ = 8192, CTXL = 256, TPB = SEQ + CTXL, MALL = NB * TPB, DMOD = 1024;
constexpr int NCH = TPB / 128;
constexpr int PW = 4096;
constexpr int PC_Z = 0, PC_XBC = 512, PC_DT = 1280, PC_DQ = 1296, PC_DK = 1808, PC_DV = 2320, PC_GQ = 2832, PC_GK = 3344, PC_GV = 3472, PC_U = 3600;
constexpr int PC_YD = 512, PC_XM = 1296;
constexpr int FFH = 2816;
constexpr float EPS = 1e-6f;
constexpr float QSCALE = 0.125f * 1.4426950408889634f;
constexpr int NTHR = 512;

constexpr size_t KiB = 1024, MiB = 1024 * 1024;
constexpr size_t WS_MOD = 0;
constexpr size_t WS_LAM = 250 * KiB;
constexpr size_t WS_QCTR = 252 * KiB;
constexpr size_t WS_BAR = 254 * KiB;
constexpr size_t WS_DEC = 256 * KiB;
constexpr size_t WS_HC = 512 * KiB;
constexpr size_t WS_WT = 4 * MiB + 512 * KiB;
constexpr size_t WT_IN = 0, WT_G = WT_IN + (size_t)4096 * 1024 * 2, WT_BR = WT_G + (size_t)4096 * 1024 * 2, WT_O = WT_BR + (size_t)1024 * 1920 * 2,
                 WT_GU = WT_O + (size_t)1024 * 1024 * 2, WT_DN = WT_GU + (size_t)5632 * 1024 * 2, WT_GLU = WT_DN + (size_t)1024 * 2816 * 2, WT_END = WT_GLU + (size_t)768 * 384 * 2;
constexpr size_t WS_XN = 43 * MiB + 512 * KiB;
constexpr size_t WS_P = WS_XN + 66 * MiB;
constexpr size_t WS_YB = WS_P + 264 * MiB;
constexpr size_t WS_ARENA = WS_YB + 33 * MiB;
constexpr size_t WS_XBC = WS_ARENA;
constexpr size_t WS_SST = WS_XBC + 49 * MiB + 512 * KiB;
constexpr size_t WS_DT = WS_SST + 33 * MiB;
constexpr size_t WS_S5 = WS_DT + 2 * MiB + 256 * KiB;
constexpr size_t WS_MS = WS_ARENA;
constexpr size_t WS_GS = WS_ARENA + 64 * MiB;
constexpr size_t WS_SSQ = 503 * MiB;
constexpr size_t WS_XBAR = 506 * MiB;
constexpr size_t WS_NEED = 512 * MiB;
static_assert(WT_END <= 39 * MiB, "wt");
static_assert(WS_S5 + 7 * MiB <= WS_SSQ && WS_GS + 32 * MiB <= WS_SSQ && WS_SSQ + MiB <= WS_NEED && (size_t)MALL * PW * 2 <= 264 * MiB, "ws map");

constexpr int LDS_TOTAL = 152 * 1024;

struct Args { const float* in[42]; float* out; unsigned char* ws; int ph_lo, ph_hi; };

__device__ __forceinline__ size_t ozero() { size_t z = 0; asm volatile("" : "+s"(z)); return z; }
__device__ __forceinline__ const float* oin(const Args& A, int i) { return A.in[i] + ozero(); }
__device__ __forceinline__ unsigned char* ows(const Args& A) { return A.ws + ozero(); }
__device__ __forceinline__ float* oout(const Args& A) { return A.out + ozero(); }
__device__ __forceinline__ int obid() { int b = __builtin_amdgcn_readfirstlane((int)blockIdx.x); asm volatile("" : "+s"(b)); return b; }
__device__ __forceinline__ int ogrid() { int b = __builtin_amdgcn_readfirstlane((int)gridDim.x); asm volatile("" : "+s"(b)); return b; }
typedef __bf16 hwbf16x2_t __attribute__((ext_vector_type(2)));
__device__ __forceinline__ unsigned pk2(float lo, float hi) { const f32x2 v = {lo, hi}; return __builtin_bit_cast(unsigned, __builtin_convertvector(v, hwbf16x2_t)); }
__device__ __forceinline__ unsigned f2bf(float f) { return pk2(f, 0.f) & 0xffffu; }
__device__ __forceinline__ float bf2f(unsigned short h) { return __builtin_bit_cast(float, (unsigned)h << 16); }
__device__ __forceinline__ float bflo(unsigned v) { return __builtin_bit_cast(float, v << 16); }
__device__ __forceinline__ float bfhi(unsigned v) { return __builtin_bit_cast(float, v & 0xffff0000u); }
__device__ __forceinline__ float wave_sum(float v) {
    v += __builtin_bit_cast(float, __builtin_amdgcn_update_dpp(0, __builtin_bit_cast(int, v), 0xB1, 0xF, 0xF, true));
    v += __builtin_bit_cast(float, __builtin_amdgcn_update_dpp(0, __builtin_bit_cast(int, v), 0x4E, 0xF, 0xF, true));
    v += __builtin_bit_cast(float, __builtin_amdgcn_update_dpp(0, __builtin_bit_cast(int, v), 0x141, 0xF, 0xF, true));
    v += __builtin_bit_cast(float, __builtin_amdgcn_update_dpp(0, __builtin_bit_cast(int, v), 0x140, 0xF, 0xF, true));
    v += __shfl_xor(v, 16); v += __shfl_xor(v, 32);
    return v;
}
__device__ __forceinline__ float sigmoidf_(float x) { return __builtin_amdgcn_rcpf(1.f + __expf(-x)); }
__device__ __forceinline__ float siluf_(float x) { return x * __builtin_amdgcn_rcpf(1.f + __expf(-x)); }
#define LDSW() asm volatile("s_waitcnt lgkmcnt(0)" ::: "memory")
#define XB_TMO      128
#define XB_XCNT(j)  (256  + 64 * (j))
#define XB_XSUB(j)  (1280 + 64 * (j))
#define XB_XGEN(j)  (2304 + 64 * (j))
#define XB_TOP      3328
#define XB_TOPGEN   3392
#define XCD_BAR_WORDS 3456
#define XB_SPIN_CAP (1u << 18)

__device__ __forceinline__ unsigned xb_ld(unsigned* p)              { return __hip_atomic_load(p, __ATOMIC_RELAXED, __HIP_MEMORY_SCOPE_AGENT); }
__device__ __forceinline__ unsigned xb_add(unsigned* p, unsigned v) { return __hip_atomic_fetch_add(p, v, __ATOMIC_RELAXED, __HIP_MEMORY_SCOPE_AGENT); }
__device__ __forceinline__ unsigned xb_xcc_id() { return (unsigned)__builtin_amdgcn_s_getreg((3 << 11) | 20) & 0xFu; }
#define XB_SPIN(cond, bar) do { unsigned _sp = 0; while (cond) { __builtin_amdgcn_s_sleep(1); \
    if ((++_sp & 255u) == 0u) { if (xb_ld(&(bar)[XB_TMO])) break; if (_sp > XB_SPIN_CAP) { atomicAdd(&(bar)[XB_TMO], 1u); break; } } } } while (0)

struct XcdBarrier {
    unsigned* bar; unsigned x;
    volatile unsigned* st;
};

__device__ __forceinline__ XcdBarrier xcd_barrier_post(unsigned* bar, volatile unsigned* st) {
    XcdBarrier b; b.bar = bar; b.x = xb_xcc_id(); b.st = st;
    if (otid() == 0) (void)xb_add(&bar[XB_XCNT(b.x)], 1u);
    return b;
}
__device__ __forceinline__ void xcd_barrier_complete(unsigned* bar, unsigned x, unsigned& nloc, unsigned& nx) {
    const unsigned G = gridDim.x * gridDim.y * gridDim.z;
    unsigned sum, cnt, mine, sp = 0u;
    for (;;) {
        sum = 0u; cnt = 0u; mine = 0u;
#pragma unroll
        for (unsigned j = 0; j < 16; ++j) { const unsigned c = xb_ld(&bar[XB_XCNT(j)]); sum += c; cnt += (c > 0u) ? 1u : 0u; mine = (j == x) ? c : mine; }
        if (sum == G) break;
        __builtin_amdgcn_s_sleep(1);
        if ((++sp & 255u) == 0u) { if (xb_ld(&bar[XB_TMO])) break; if (sp > XB_SPIN_CAP) { atomicAdd(&bar[XB_TMO], 1u); break; } }
    }
    nloc = mine > 0u ? mine : 1u; nx = cnt > 0u ? cnt : 1u;
}

__device__ __forceinline__ void xcd_barrier(const XcdBarrier& b) {
    asm volatile("s_waitcnt vmcnt(0)" ::: "memory");
    __syncthreads();
    if (otid() == 0) {
        unsigned* bar = b.bar;
        __builtin_amdgcn_s_waitcnt(0);
        unsigned nloc = b.st[0], nx = b.st[1];
        if (nloc == 0u) { xcd_barrier_complete(bar, b.x, nloc, nx); b.st[0] = nloc; b.st[1] = nx; }
        const unsigned old = xb_add(&bar[XB_XSUB(b.x)], 1u);
        const unsigned gen = old / nloc;
        if (old + 1u == (gen + 1u) * nloc) {
            __builtin_amdgcn_fence(__ATOMIC_RELEASE, "agent");
            asm volatile("s_waitcnt vmcnt(0)" ::: "memory");
            const unsigned og = xb_add(&bar[XB_TOP], 1u);
            const unsigned tg = og / nx;
            if (og + 1u == (tg + 1u) * nx) xb_add(&bar[XB_TOPGEN], 1u);
            else XB_SPIN(xb_ld(&bar[XB_TOPGEN]) == tg, bar);
            __builtin_amdgcn_fence(__ATOMIC_ACQUIRE, "agent");
            xb_add(&bar[XB_XGEN(b.x)], 1u);
            asm volatile("s_waitcnt vmcnt(0)" ::: "memory");
        } else {
            XB_SPIN(xb_ld(&bar[XB_XGEN(b.x)]) == gen, bar);
            __builtin_amdgcn_fence(__ATOMIC_ACQUIRE, "agent");
            asm volatile("s_waitcnt vmcnt(0)" ::: "memory");
        }
    }
    __syncthreads();
}
constexpr int LDS_XBST_OFF = 152 * 1024 - 16 - 256 - 16;
__device__ __forceinline__ void grid_barrier(unsigned* bar) {
    XcdBarrier b; b.bar = bar; b.x = xb_xcc_id(); b.st = (volatile unsigned*)(g_lds_ + LDS_XBST_OFF);
    xcd_barrier(b);
}
struct RSched {
    pg8::StaticOrder so; int skip;
    __device__ __forceinline__ void init(int N, int G, int c, bool skipctx) { so.init((skipctx ? 128 : 132) * 256, N, G, c); skip = skipctx ? 1 : 0; }
    __device__ __forceinline__ bool next(int i, pg8::Unit& u) const { if (!so.next(i, u)) return false; if (skip) u.pm = u.pm + u.pm / 32 + 1; return true; }
    __device__ __forceinline__ void a_ready(const pg8::Unit&) const {}
    __device__ __forceinline__ void done(const pg8::Unit&) const {}
};
struct OneSched {
    pg8::Unit u;
    __device__ __forceinline__ bool next(int i, pg8::Unit& o) const { if (i != 0) return false; o = u; return true; }
    __device__ __forceinline__ void a_ready(const pg8::Unit&) const {}
    __device__ __forceinline__ void done(const pg8::Unit&) const {}
};

struct EpiStore {
    static constexpr bool PERM = true, AFTER_DRAIN = false, BIAS_INIT = false;
    bf16* O; int ldc;
    __device__ __forceinline__ void operator()(const pg8::f32x4 (&acc)[2][2][4][2], const pg8::Unit& u, int wr, int wc, int fr, int fq) const {
        const int row0 = u.pm * 256 + wr * 64 + fr, col0 = u.pn * 256 + wc * 32 + 8 * fq;
#pragma unroll
        for (int ai = 0; ai < 2; ++ai)
#pragma unroll
            for (int m = 0; m < 4; ++m) { bf16* rowp = O + (size_t)(row0 + ai * 128 + m * 16) * ldc + col0;
#pragma unroll
                for (int bj = 0; bj < 2; ++bj) { const pg8::f32x4 v0 = acc[ai][bj][m][0], v1 = acc[ai][bj][m][1];
                    v4u w; w.x = pg8::cvt_pk_bf16(v0[0], v0[1]); w.y = pg8::cvt_pk_bf16(v0[2], v0[3]); w.z = pg8::cvt_pk_bf16(v1[0], v1[1]); w.w = pg8::cvt_pk_bf16(v1[2], v1[3]);
                    __builtin_nontemporal_store(w, (v4u*)(rowp + bj * 128)); } }
    }
};
template <int ACT> struct EpiPair {
    static constexpr bool PERM = true, AFTER_DRAIN = false, BIAS_INIT = (ACT == 1);
    bf16* O; int ldc; const float* bias; int half;
    __device__ __forceinline__ void init(pg8::f32x4 (&acc)[2][2][4][2], const pg8::Unit& u, int wc, int fq) const {
        const float* bp = bias + u.pn * 128 + wc * 32 + 8 * fq;
#pragma unroll
        for (int bj = 0; bj < 2; ++bj)
#pragma unroll
            for (int n = 0; n < 2; ++n) { const pg8::f32x4 bv = *(const pg8::f32x4*)(bp + bj * half + 4 * n);
#pragma unroll
                for (int ai = 0; ai < 2; ++ai)
#pragma unroll
                    for (int m = 0; m < 4; ++m) acc[ai][bj][m][n] = bv; }
    }
    __device__ __forceinline__ void operator()(const pg8::f32x4 (&acc)[2][2][4][2], const pg8::Unit& u, int wr, int wc, int fr, int fq) const {
        const int row0 = u.pm * 256 + wr * 64 + fr, col0 = u.pn * 128 + wc * 32 + 8 * fq;
#pragma unroll
        for (int ai = 0; ai < 2; ++ai) { bf16* rowp = O + (size_t)(row0 + ai * 128) * ldc + col0; asm volatile("" : "+v"(rowp));
#pragma unroll
            for (int m = 0; m < 4; ++m) { float o[8];
#pragma unroll
                for (int n = 0; n < 2; ++n)
#pragma unroll
                    for (int j = 0; j < 4; ++j) { const float a = acc[ai][0][m][n][j], b = acc[ai][1][m][n][j];
                        o[n * 4 + j] = (ACT == 0) ? siluf_(a) * b : a * sigmoidf_(b); }
                v4u w; w.x = pg8::cvt_pk_bf16(o[0], o[1]); w.y = pg8::cvt_pk_bf16(o[2], o[3]); w.z = pg8::cvt_pk_bf16(o[4], o[5]); w.w = pg8::cvt_pk_bf16(o[6], o[7]);
                __builtin_nontemporal_store(w, (v4u*)rowp); rowp += (size_t)16 * ldc; asm volatile("" : "+v"(rowp)); } }
    }
};
struct EpiRes {
    static constexpr bool PERM = false, AFTER_DRAIN = false, BIAS_INIT = false;
    const float* base_lat; const float* base_ctx; float* out_lat; float* out_ctx; const float* mod; int goff;
    __device__ __forceinline__ void operator()(const pg8::f32x4 (&acc)[2][2][4][2], const pg8::Unit& u, int wr, int wc, int fr, int fq) const {
        const int b = u.pm / 33, kb = u.pm % 33;
        const float* bp; float* op; const float* gp;
        if (kb == 0) { bp = base_ctx + (size_t)b * CTXL * DMOD; op = out_ctx + (size_t)b * CTXL * DMOD; gp = mod + 4 * 6144 + goff; }
        else { const size_t off = ((size_t)b * SEQ + (size_t)(kb - 1) * 256) * DMOD; bp = base_lat + off; op = out_lat + off; gp = mod + b * 6144 + goff; }
        const int col0 = u.pn * 256 + wc * 32 + 4 * fq;
#pragma unroll
        for (int bj = 0; bj < 2; ++bj)
#pragma unroll
            for (int n = 0; n < 2; ++n) {
                const int col = col0 + bj * 128 + n * 16; const pg8::f32x4 gv = *(const pg8::f32x4*)(gp + col); pg8::f32x4 bs[8];
#pragma unroll
                for (int ai = 0; ai < 2; ++ai)
#pragma unroll
                    for (int m = 0; m < 4; ++m) bs[ai * 4 + m] = *(const pg8::f32x4*)(bp + (size_t)(ai * 128 + wr * 64 + m * 16 + fr) * DMOD + col);
#pragma unroll
                for (int ai = 0; ai < 2; ++ai)
#pragma unroll
                    for (int m = 0; m < 4; ++m) *(pg8::f32x4*)(op + (size_t)(ai * 128 + wr * 64 + m * 16 + fr) * DMOD + col) = bs[ai * 4 + m] + gv * acc[ai][bj][m][n];
                asm volatile("" ::: "memory"); }
    }
};
#define OPQ(p) asm volatile("" : "+v"(p))
struct EpiGate {
    static constexpr bool PERM = true, AFTER_DRAIN = false, BIAS_INIT = false;
    v4u* Gs;
    __device__ __forceinline__ void operator()(const pg8::f32x4 (&acc)[2][2][4][2], const pg8::Unit& u, int wr, int wc, int fr, int fq) const {
        v4u* gp = Gs + otid(); OPQ(gp);
#pragma unroll
        for (int ai = 0; ai < 2; ++ai)
#pragma unroll
            for (int bj = 0; bj < 2; ++bj)
#pragma unroll
                for (int m = 0; m < 4; ++m) { const pg8::f32x4 v0 = acc[ai][bj][m][0], v1 = acc[ai][bj][m][1]; v4u w;
                    w.x = pg8::cvt_pk_bf16(sigmoidf_(v0[0]), sigmoidf_(v0[1])); w.y = pg8::cvt_pk_bf16(sigmoidf_(v0[2]), sigmoidf_(v0[3]));
                    w.z = pg8::cvt_pk_bf16(sigmoidf_(v1[0]), sigmoidf_(v1[1])); w.w = pg8::cvt_pk_bf16(sigmoidf_(v1[2]), sigmoidf_(v1[3]));
                    *gp = w; gp += 512; OPQ(gp); }
    }
};
struct EpiBranch {
    static constexpr bool PERM = true, AFTER_DRAIN = false, BIAS_INIT = false;
    const v4u* Gs; v4u* Ms; bf16* XM; int ldc; int first, last; const float* ssq;
    __device__ __forceinline__ void operator()(const pg8::f32x4 (&acc)[2][2][4][2], const pg8::Unit& u, int wr, int wc, int fr, int fq) const {
        const int tid = otid(); const int row0 = u.pm * 256 + wr * 64 + fr, col0 = u.pn * 256 + wc * 32 + 8 * fq;
        const v4u* gp = Gs + tid; v4u* mp = Ms + tid; OPQ(gp); OPQ(mp);
#pragma unroll
        for (int ai = 0; ai < 2; ++ai)
#pragma unroll
            for (int bj = 0; bj < 2; ++bj) { bf16* xp = XM + (size_t)(row0 + ai * 128) * ldc + col0 + bj * 128; OPQ(xp);
                v4u gw[4], pm_[4]; float rs[4];
#pragma unroll
                for (int m = 0; m < 4; ++m) { gw[m] = gp[m * 512]; if (!first) pm_[m] = mp[m * 512]; else pm_[m] = (v4u){0u, 0u, 0u, 0u};
                    rs[m] = 1.f; if (first) { const f32x2 sq = *(const f32x2*)(ssq + (size_t)(row0 + ai * 128 + m * 16) * 2); rs[m] = rsqrtf((sq.x + sq.y) * (1.f / 512.f) + EPS); } }
#pragma unroll
                for (int m = 0; m < 4; ++m) {
                    pg8::f32x4 g0 = {bflo(gw[m].x), bfhi(gw[m].x), bflo(gw[m].y), bfhi(gw[m].y)}, g1 = {bflo(gw[m].z), bfhi(gw[m].z), bflo(gw[m].w), bfhi(gw[m].w)};
                    pg8::f32x4 m0 = g0 * acc[ai][bj][m][0] * rs[m], m1 = g1 * acc[ai][bj][m][1] * rs[m];
                    m0 += (pg8::f32x4){bflo(pm_[m].x), bfhi(pm_[m].x), bflo(pm_[m].y), bfhi(pm_[m].y)}; m1 += (pg8::f32x4){bflo(pm_[m].z), bfhi(pm_[m].z), bflo(pm_[m].w), bfhi(pm_[m].w)};
                    v4u w; w.x = pg8::cvt_pk_bf16(m0[0], m0[1]); w.y = pg8::cvt_pk_bf16(m0[2], m0[3]); w.z = pg8::cvt_pk_bf16(m1[0], m1[1]); w.w = pg8::cvt_pk_bf16(m1[2], m1[3]);
                    if (last) *(v4u*)(xp + (size_t)(m * 16) * ldc) = w; else mp[m * 512] = w; }
                gp += 2048; mp += 2048; OPQ(gp); OPQ(mp); }
    }
};
struct EpiMerge {
    static constexpr bool PERM = true, AFTER_DRAIN = false, BIAS_INIT = false;
    v4u* Gs; v4u* Ms; bf16* XM; int ldc; const float* ssq;
    __device__ __forceinline__ void operator()(const pg8::f32x4 (&acc)[2][2][4][2], const pg8::Unit& u, int wr, int wc, int fr, int fq) const {
        v4u* gt = Gs + (size_t)((u.aux >> 1) & 1) * 8192;
        if ((u.aux & 1) == 0) { EpiGate E{gt}; E(acc, u, wr, wc, fr, fq); }
        else { EpiBranch E{gt, Ms, XM, ldc, (u.aux >> 1) == 0, (u.aux >> 1) == 3, ssq}; E(acc, u, wr, wc, fr, fq); }
    }
};

__device__ __forceinline__ int scan_chunk(int dir, int k) { return dir == 0 ? k : (k < 2 ? 1 - k : 67 - k); }

__device__ __forceinline__ void phase_mod(const Args& A, unsigned char* lds) {
    float* sc = (float*)lds; float* red = sc + 5 * 1024;
    const int tid = otid();
    float* MOD = (float*)(ows(A) + WS_MOD);
    for (int i = tid; i < 5 * 1024; i += NTHR) { const float v = (i < 4096) ? oin(A, 1)[i] : oin(A, 3)[i - 4096]; sc[i] = siluf_(v); }
    __syncthreads();
    for (int item = obid(); item < 192; item += ogrid()) {
        const int l = item / 96, jb = item % 96, kp = tid >> 6, jj = tid & 63, j = jb * 64 + jj;
        const float* w = oin(A, 4) + (size_t)l * 1024 * 6144 + j;
        float a0 = 0.f, a1 = 0.f, a2 = 0.f, a3 = 0.f, a4 = 0.f;
#pragma unroll 8
        for (int k = kp * 128; k < kp * 128 + 128; ++k) { const float wv = w[(size_t)k * 6144];
            a0 += sc[k] * wv; a1 += sc[1024 + k] * wv; a2 += sc[2048 + k] * wv; a3 += sc[3072 + k] * wv; a4 += sc[4096 + k] * wv; }
        red[(kp * 5 + 0) * 64 + jj] = a0; red[(kp * 5 + 1) * 64 + jj] = a1; red[(kp * 5 + 2) * 64 + jj] = a2; red[(kp * 5 + 3) * 64 + jj] = a3; red[(kp * 5 + 4) * 64 + jj] = a4;
        __syncthreads();
        if (tid < 320) { const int s = tid >> 6, j2 = tid & 63; float t = oin(A, 5)[l * 6144 + jb * 64 + j2];
#pragma unroll
            for (int q = 0; q < 8; ++q) t += red[(q * 5 + s) * 64 + j2];
            MOD[(size_t)(l * 5 + s) * 6144 + jb * 64 + j2] = t; }
        __syncthreads();
    }
    if (obid() == 0 && tid < 256) ((unsigned*)(ows(A) + WS_QCTR))[tid] = 0u;
    if (obid() == 0 && tid < 2) { const int l = tid; float s1 = 0.f, s2 = 0.f;
        for (int i = 0; i < 64; ++i) { s1 += oin(A, 17)[l * 64 + i] * oin(A, 18)[l * 64 + i]; s2 += oin(A, 19)[l * 64 + i] * oin(A, 20)[l * 64 + i]; }
        const float lam_init = 0.8f - 0.6f * expf(-0.3f * (float)l);
        ((float*)(ows(A) + WS_LAM))[l] = expf(s1) - expf(s2) + lam_init; }
}

struct WItem { const float* W; bf16* WT; const float* ks; int K, N, row_off, half, mode, it; };
__device__ __forceinline__ WItem wconv_desc(const Args& A, int L, int idx) {
    unsigned char* wt = ows(A) + WS_WT; WItem d; d.ks = nullptr; d.row_off = 0; d.half = 0; d.mode = 0;
    if (idx < 2000) { d.W = oin(A, 8) + (size_t)L * 1024 * 3984; d.K = 1024; d.N = 3984; d.WT = (bf16*)(wt + WT_IN); d.it = idx; }
    else if (idx < 4048) { const int i = (idx - 2000) >> 9; d.W = oin(A, 34) + (size_t)(L * 4 + i) * 1024 * 1024; d.K = 1024; d.N = 1024; d.WT = (bf16*)(wt + WT_G); d.row_off = i * 1024; d.it = (idx - 2000) & 511; }
    else if (idx < 4816) { const int j = (idx - 4048) >> 8; d.W = oin(A, j == 0 ? 35 : j == 1 ? 36 : 37) + (size_t)L * 512 * 1024; d.K = 512; d.N = 1024; d.WT = (bf16*)(wt + WT_BR + (size_t)j * 1024 * 512 * 2); d.it = (idx - 4048) & 255;
        if (j == 0) { d.mode = 2; d.ks = oin(A, 14) + L * 512; } }
    else if (idx < 5008) { d.W = oin(A, 38) + (size_t)L * 384 * 1024; d.K = 384; d.N = 1024; d.WT = (bf16*)(wt + WT_BR + (size_t)3 * 1024 * 512 * 2); d.it = idx - 4816; }
    else if (idx < 5520) { d.W = oin(A, 39) + (size_t)L * 1024 * 1024; d.K = 1024; d.N = 1024; d.WT = (bf16*)(wt + WT_O); d.it = idx - 5008; }
    else if (idx < 8336) { d.W = oin(A, 40) + (size_t)L * 1024 * 5632; d.K = 1024; d.N = 5632; d.WT = (bf16*)(wt + WT_GU); d.mode = 1; d.half = 2816; d.it = idx - 5520; }
    else if (idx < 9744) { d.W = oin(A, 41) + (size_t)L * 2816 * 1024; d.K = 2816; d.N = 1024; d.WT = (bf16*)(wt + WT_DN); d.it = idx - 8336; }
    else { d.W = oin(A, 32) + (size_t)L * 384 * 768; d.K = 384; d.N = 768; d.WT = (bf16*)(wt + WT_GLU); d.mode = 1; d.half = 384; d.it = idx - 9744; }
    return d;
}
__device__ __forceinline__ void wconv_load(const WItem& d, int lane, float (&v)[32]) {
    const int nblk = (d.N + 31) >> 5, kb = d.it / nblk, nb = d.it - kb * nblk, k0 = 64 * kb, nl = 32 * nb + (lane & 31);
#pragma unroll
    for (int i = 0; i < 32; ++i) { const int kk = 2 * i + (lane >> 5); v[i] = (nl < d.N) ? d.W[(size_t)(k0 + kk) * d.N + nl] : 0.f; }
}
__device__ __forceinline__ void wconv_store(const WItem& d, int lane, const float (&v)[32], float* scr) {
    const int nblk = (d.N + 31) >> 5, kb = d.it / nblk, nb = d.it - kb * nblk, k0 = 64 * kb, n0 = 32 * nb;
#pragma unroll
    for (int i = 0; i < 32; ++i) scr[(2 * i + (lane >> 5)) * 33 + (lane & 31)] = v[i];
    LDSW();
    const int c = lane & 7;
#pragma unroll
    for (int j = 0; j < 4; ++j) { const int n = (lane >> 3) + 8 * j, ng = n0 + n; const float* s = scr + (8 * c) * 33 + n;
        if (ng < d.N) {
            const int orow = (d.mode == 1) ? ((ng < d.half) ? ((ng >> 7) * 256 + (ng & 127)) : (((ng - d.half) >> 7) * 256 + 128 + ((ng - d.half) & 127))) : d.row_off + ng;
            f32x4 ka = {1.f, 1.f, 1.f, 1.f}, kb2 = ka;
            if (d.mode == 2) { ka = *(const f32x4*)(d.ks + k0 + 8 * c); kb2 = *(const f32x4*)(d.ks + k0 + 8 * c + 4); }
            v4u o; o.x = pk2(s[0 * 33] * ka.x, s[1 * 33] * ka.y); o.y = pk2(s[2 * 33] * ka.z, s[3 * 33] * ka.w); o.z = pk2(s[4 * 33] * kb2.x, s[5 * 33] * kb2.y); o.w = pk2(s[6 * 33] * kb2.z, s[7 * 33] * kb2.w);
            *(v4u*)(d.WT + (size_t)orow * d.K + k0 + 8 * c) = o; } }
    LDSW();
}
__device__ __forceinline__ void phase_wconv(const Args& A, int L, unsigned char* lds) {
    const int tid = otid(), lane = tid & 63, wid = tid >> 6;
    float* scr = (float*)(lds + wid * 8704);
    const int ngw = ogrid() * 8, gw = obid() * 8 + wid;
    constexpr int NITEMS = 9888;
    for (int i = obid() * NTHR + tid; i < 112 * 1024 / 8; i += ogrid() * NTHR) ((v4u*)(ows(A) + WS_WT + WT_IN + (size_t)3984 * 1024 * 2))[i] = (v4u){0u, 0u, 0u, 0u};
    if (gw < NITEMS) {
        float v[32]; { const WItem d0 = wconv_desc(A, L, gw); wconv_load(d0, lane, v); }
        for (int idx = gw; idx < NITEMS; idx += ngw) {
            const int nidx = idx + ngw; float v2[32];
            if (nidx < NITEMS) { const WItem dn = wconv_desc(A, L, nidx); wconv_load(dn, lane, v2); }
            { const WItem dc = wconv_desc(A, L, idx); wconv_store(dc, lane, v, scr); }
#pragma unroll
            for (int i = 0; i < 32; ++i) v[i] = v2[i];
        }
    }
}

__device__ __forceinline__ void phase_norm(const Args& A, const float* lat, const float* ctx, const float* g, const float* mod, int sh_off, int sc_off, bool skipctx) {
    const int tid = otid(), lane = tid & 63, wid = tid >> 6;
    bf16* XN = (bf16*)(ows(A) + WS_XN);
    const int nw = ogrid() * 8;
    for (int r0 = obid() * 8 + wid; r0 < MALL; r0 += 2 * nw) {
        const float* src[2]; const float* mv[2]; bool ok[2]; f32x4 v[2][4];
#pragma unroll
        for (int q = 0; q < 2; ++q) { const int r = r0 + q * nw; ok[q] = r < MALL; const int rr = ok[q] ? r : r0; const int b = rr / TPB, t = rr - b * TPB;
            if (t < CTXL) { if (skipctx) ok[q] = false; src[q] = ctx + ((size_t)b * CTXL + t) * DMOD; mv[q] = mod + 4 * 6144; }
            else { src[q] = lat + ((size_t)b * SEQ + (t - CTXL)) * DMOD; mv[q] = mod + b * 6144; }
#pragma unroll
            for (int j = 0; j < 4; ++j) v[q][j] = *(const f32x4*)(src[q] + 4 * lane + 256 * j); }
#pragma unroll
        for (int q = 0; q < 2; ++q) { float ss = 0.f;
#pragma unroll
            for (int j = 0; j < 4; ++j) ss += (v[q][j].x * v[q][j].x + v[q][j].y * v[q][j].y) + (v[q][j].z * v[q][j].z + v[q][j].w * v[q][j].w);
            const float rstd = rsqrtf(wave_sum(ss) * (1.f / DMOD) + EPS);
            if (ok[q]) {
#pragma unroll
                for (int j = 0; j < 4; ++j) { const int col = 4 * lane + 256 * j; const f32x4 gg = *(const f32x4*)(g + col), sh = *(const f32x4*)(mv[q] + sh_off + col), sc = *(const f32x4*)(mv[q] + sc_off + col);
                    const f32x4 y = v[q][j] * rstd * gg * (sc + 1.f) + sh; v2u o; o.x = pk2(y.x, y.y); o.y = pk2(y.z, y.w);
                    *(v2u*)(XN + (size_t)(r0 + q * nw) * DMOD + col) = o; } } }
    }
}

__device__ __forceinline__ float dpp_sum16(float x) {
    x += __builtin_bit_cast(float, __builtin_amdgcn_update_dpp(0, __builtin_bit_cast(int, x), 0xB1, 0xF, 0xF, true));
    x += __builtin_bit_cast(float, __builtin_amdgcn_update_dpp(0, __builtin_bit_cast(int, x), 0x4E, 0xF, 0xF, true));
    x += __builtin_bit_cast(float, __builtin_amdgcn_update_dpp(0, __builtin_bit_cast(int, x), 0x141, 0xF, 0xF, true));
    x += __builtin_bit_cast(float, __builtin_amdgcn_update_dpp(0, __builtin_bit_cast(int, x), 0x140, 0xF, 0xF, true));
    return x;
}
__device__ __forceinline__ void phase_prep(const Args& A, int L) {
    const int tid = otid(), lane = tid & 63, wid = tid >> 6;
    bf16* P = (bf16*)(ows(A) + WS_P); bf16* XBC = (bf16*)(ows(A) + WS_XBC); float* DT = (float*)(ows(A) + WS_DT);
    {
        const float* dtb = oin(A, 12) + L * 16;
        for (int idx = obid() * NTHR + tid; idx < MALL * 16; idx += ogrid() * NTHR) { const int r = idx >> 4, j = idx & 15;
            const float raw = bf2f(P[(size_t)r * PW + PC_DT + j]) + dtb[j]; DT[idx] = raw > 20.f ? raw : log1pf(expf(raw)); }
    }
    if (tid < 480) {
        const int cg = tid % 96, tsub = tid / 96; const float* cw = oin(A, 9) + (size_t)L * 5 * 768 + cg * 8; const float* cb = oin(A, 10) + L * 768 + cg * 8;
        float w[5][8], bias[8];
#pragma unroll
        for (int j = 0; j < 5; ++j) { const f32x4 a = *(const f32x4*)(cw + j * 768), b = *(const f32x4*)(cw + j * 768 + 4);
            w[j][0] = a.x; w[j][1] = a.y; w[j][2] = a.z; w[j][3] = a.w; w[j][4] = b.x; w[j][5] = b.y; w[j][6] = b.z; w[j][7] = b.w; }
        { const f32x4 a = *(const f32x4*)cb, b = *(const f32x4*)(cb + 4); bias[0] = a.x; bias[1] = a.y; bias[2] = a.z; bias[3] = a.w; bias[4] = b.x; bias[5] = b.y; bias[6] = b.z; bias[7] = b.w; }
        const int cstep = ogrid() * 5;
        for (int rbase = obid() * 5 + tsub; rbase < MALL; rbase += 2 * cstep) {
            v4u xin[2][5]; bool okk[2][5];
#pragma unroll
            for (int q = 0; q < 2; ++q) { const int r = rbase + q * cstep; const int rr = r < MALL ? r : rbase; const int t = rr % TPB; const int seg_lo = (t < CTXL) ? 0 : CTXL, seg_hi = (t < CTXL) ? CTXL : TPB;
#pragma unroll
                for (int j = 0; j < 5; ++j) { const int tt = t + j - 2; okk[q][j] = (tt >= seg_lo && tt < seg_hi);
                    xin[q][j] = okk[q][j] ? *(const v4u*)(P + (size_t)(rr + j - 2) * PW + PC_XBC + cg * 8) : (v4u){0u, 0u, 0u, 0u}; } }
#pragma unroll
            for (int q = 0; q < 2; ++q) { const int r = rbase + q * cstep;
                float acc[8];
#pragma unroll
                for (int e = 0; e < 8; ++e) acc[e] = bias[e];
#pragma unroll
                for (int j = 0; j < 5; ++j) { const v4u x = xin[q][j];
                    acc[0] += w[j][0] * bflo(x.x); acc[1] += w[j][1] * bfhi(x.x); acc[2] += w[j][2] * bflo(x.y); acc[3] += w[j][3] * bfhi(x.y);
                    acc[4] += w[j][4] * bflo(x.z); acc[5] += w[j][5] * bfhi(x.z); acc[6] += w[j][6] * bflo(x.w); acc[7] += w[j][7] * bfhi(x.w); }
                v4u o; o.x = pk2(siluf_(acc[0]), siluf_(acc[1])); o.y = pk2(siluf_(acc[2]), siluf_(acc[3])); o.z = pk2(siluf_(acc[4]), siluf_(acc[5])); o.w = pk2(siluf_(acc[6]), siluf_(acc[7]));
                if (r < MALL) *(v4u*)(XBC + (size_t)r * 768 + cg * 8) = o; }
        }
    }
    {
        const int sub = lane >> 4, li = lane & 15, base = (li < 8) ? 2 * li : 32 + 2 * (li - 8);
        float g[4][4];
#pragma unroll
        for (int ty = 0; ty < 4; ++ty) { const float* gp = oin(A, ty == 0 ? 15 : ty == 1 ? 16 : ty == 2 ? 22 : 23) + L * 64 + base; g[ty][0] = gp[0]; g[ty][1] = gp[1]; g[ty][2] = gp[16]; g[ty][3] = gp[17]; }
        const float if0 = powf(10000.f, -(float)(base & 15) / 16.f), if1 = powf(10000.f, -(float)((base + 1) & 15) / 16.f);
        const int nw = ogrid() * 8;
        for (int rbase = obid() * 8 + wid; rbase < MALL; rbase += 2 * nw) {
            unsigned ra[2][7], rb[2][7]; float c0[2], s0[2], c1[2], s1[2]; bf16* prow[2]; bool okr[2];
#pragma unroll
            for (int q = 0; q < 2; ++q) { const int r = rbase + q * nw; okr[q] = r < MALL; const int rr = okr[q] ? r : rbase; prow[q] = P + (size_t)rr * PW;
#pragma unroll
                for (int it = 0; it < 7; ++it) { const int hd = it * 4 + sub; const int hc = hd < 26 ? hd : 25;
                    const int cc = (hc < 8) ? PC_DQ + hc * 64 : (hc < 16) ? PC_DK + (hc - 8) * 64 : (hc < 24) ? PC_GQ + (hc - 16) * 64 : PC_GK + (hc - 24) * 64;
                    ra[q][it] = *(const unsigned*)(prow[q] + cc + base); rb[q][it] = *(const unsigned*)(prow[q] + cc + base + 16); } }
#pragma unroll
            for (int q = 0; q < 2; ++q) { const int r = rbase + q * nw; const int t = (r < MALL ? r : rbase) % TPB;
                c0[q] = 1.f; s0[q] = 0.f; c1[q] = 1.f; s1[q] = 0.f;
                if (t >= CTXL) { const int tl = t - CTXL; const float pos = (float)((li < 8) ? (tl >> 6) : (tl & 63)); sincosf(pos * if0, &s0[q], &c0[q]); sincosf(pos * if1, &s1[q], &c1[q]); } }
#pragma unroll
            for (int q = 0; q < 2; ++q) {
#pragma unroll
                for (int it = 0; it < 7; ++it) { const int hd = it * 4 + sub; const int hc = hd < 26 ? hd : 25;
                    const int cc = (hc < 8) ? PC_DQ + hc * 64 : (hc < 16) ? PC_DK + (hc - 8) * 64 : (hc < 24) ? PC_GQ + (hc - 16) * 64 : PC_GK + (hc - 24) * 64;
                    const int ty = (hc < 8) ? 0 : (hc < 16) ? 1 : (hc < 24) ? 2 : 3; const float scl = (ty == 0 || ty == 2) ? QSCALE : 1.f;
                    const float a0 = bflo(ra[q][it]), a1 = bfhi(ra[q][it]), b0 = bflo(rb[q][it]), b1 = bfhi(rb[q][it]);
                    const float ss = dpp_sum16((a0 * a0 + a1 * a1) + (b0 * b0 + b1 * b1));
                    const float rs = rsqrtf(ss * (1.f / 64.f) + EPS) * scl;
                    const float g0 = ty == 0 ? g[0][0] : ty == 1 ? g[1][0] : ty == 2 ? g[2][0] : g[3][0], g1 = ty == 0 ? g[0][1] : ty == 1 ? g[1][1] : ty == 2 ? g[2][1] : g[3][1];
                    const float g2 = ty == 0 ? g[0][2] : ty == 1 ? g[1][2] : ty == 2 ? g[2][2] : g[3][2], g3 = ty == 0 ? g[0][3] : ty == 1 ? g[1][3] : ty == 2 ? g[2][3] : g[3][3];
                    const float ya0 = a0 * rs * g0, ya1 = a1 * rs * g1, yb0 = b0 * rs * g2, yb1 = b1 * rs * g3;
                    if (hd < 26 && okr[q]) { *(unsigned*)(prow[q] + cc + base) = pk2(ya0 * c0[q] - yb0 * s0[q], ya1 * c1[q] - yb1 * s1[q]); *(unsigned*)(prow[q] + cc + base + 16) = pk2(yb0 * c0[q] + ya0 * s0[q], yb1 * c1[q] + ya1 * s1[q]); } } }
        }
    }
}

__device__ __forceinline__ void s5_coef(const Args& A, int L, int dir, int g, int p, float& ar, float& ai, f32x2 (&bb)[16]) {
    const int idx = ((L * 2 + dir) * 24 + g) * 64 + p;
    const float lr = oin(A, 24)[idx], li = oin(A, 25)[idx], step = expf(oin(A, 26)[(L * 2 + dir) * 24 + g]);
    const float mag = expf(lr * step); float s, c; sincosf(li * step, &s, &c); ar = mag * c; ai = mag * s;
    const float den = lr * lr + li * li, fr = ((ar - 1.f) * lr + ai * li) / den, fi = (ai * lr - (ar - 1.f) * li) / den;
    const float* br = oin(A, 27) + (size_t)((L * 24 + g) * 64 + p) * 16; const float* bi = oin(A, 28) + (size_t)((L * 24 + g) * 64 + p) * 16;
#pragma unroll
    for (int c4 = 0; c4 < 4; ++c4) { const f32x4 r4 = *(const f32x4*)(br + 4 * c4), i4 = *(const f32x4*)(bi + 4 * c4);
#pragma unroll
        for (int e = 0; e < 4; ++e) bb[c4 * 4 + e] = (f32x2){fr * r4[e] - fi * i4[e], fr * i4[e] + fi * r4[e]}; }
}
__device__ __forceinline__ void s5_stage_u(const bf16* P, int r0, int g, unsigned char* us, int lane) {
#pragma unroll
    for (int q = 0; q < 2; ++q) { const int tok = lane * 2 + q; const v4u* src = (const v4u*)(P + (size_t)(r0 + tok) * PW + PC_U + g * 16);
        ((v4u*)us)[tok * 2] = src[0]; ((v4u*)us)[tok * 2 + 1] = src[1]; }
    LDSW();
}
__device__ __forceinline__ void s5_setup(const Args& A, int L, int dir, int g, int lane, unsigned char* BT, float& ar, float& ai, bf16x8 (&bfr)[8]) {
    f32x2 bb[16]; s5_coef(A, L, dir, g, lane, ar, ai, bb);
#pragma unroll
    for (int c2 = 0; c2 < 8; ++c2) { *(unsigned*)(BT + (2 * lane) * 32 + c2 * 4) = pk2(bb[2 * c2].x, bb[2 * c2 + 1].x); *(unsigned*)(BT + (2 * lane + 1) * 32 + c2 * 4) = pk2(bb[2 * c2].y, bb[2 * c2 + 1].y); }
    LDSW();
    const int fr = lane & 15, fq = lane >> 4; const bf16x8 z8 = {0, 0, 0, 0, 0, 0, 0, 0};
#pragma unroll
    for (int ct = 0; ct < 8; ++ct) bfr[ct] = (fq < 2) ? *(const bf16x8*)(BT + (ct * 16 + fr) * 32 + fq * 16) : z8;
    LDSW();
}
__device__ __forceinline__ void s5_bu16(const unsigned char* us, unsigned char* BuS, int tokf, const bf16x8 (&bfr)[8], int fr, int fq) {
    const bf16x8 z8 = {0, 0, 0, 0, 0, 0, 0, 0};
    const bf16x8 af = (fq < 2) ? *(const bf16x8*)(us + tokf * 32 + fq * 16) : z8;
#pragma unroll
    for (int ct = 0; ct < 8; ++ct) { const f32x4 d = __builtin_amdgcn_mfma_f32_16x16x32_bf16(af, bfr[ct], (f32x4){0.f, 0.f, 0.f, 0.f}, 0, 0, 0);
#pragma unroll
        for (int j = 0; j < 4; ++j) *(bf16*)(BuS + (4 * fq + j) * 264 + (ct * 16 + fr) * 2) = (bf16)f2bf(d[j]); }
    LDSW();
}

__device__ __forceinline__ void phase_s1(const Args& A, int L, unsigned char* lds) {
    const int tid = otid(), lane = tid & 63, wid = tid >> 6;
    const bf16* XBC = (const bf16*)(ows(A) + WS_XBC); const float* DT = (const float*)(ows(A) + WS_DT);
    bf16* SST = (bf16*)(ows(A) + WS_SST); float* DEC = (float*)(ows(A) + WS_DEC);
    { const int hb = wid >> 2, wl = wid & 3, tl = tid & 255;
      unsigned char* XT = lds + hb * 36864; unsigned char* BT = XT + 17408; float* wgt = (float*)(XT + 34816);
      for (int item0 = obid() * 2; item0 < NB * 2 * NCH * 8; item0 += ogrid() * 2) {
        const int item = item0 + hb;
        const int h = item & 7, c = (item >> 3) % NCH, dir = (item / (8 * NCH)) & 1, b = item / (16 * NCH), g = h >> 2;
        const int r0 = b * TPB + c * 128;
        if (wl == 0) {
            const int i0 = 2 * lane, tA = dir ? 127 - i0 : i0, tB = dir ? 126 - i0 : i0 + 1;
            const float dA = DT[(size_t)(r0 + tA) * 16 + dir * 8 + h], dB = DT[(size_t)(r0 + tB) * 16 + dir * 8 + h];
            const float aneg = -expf(oin(A, 11)[L * 16 + dir * 8 + h]); const float a0 = dA * aneg, a1 = dB * aneg;
            float sc = a0 + a1;
#pragma unroll
            for (int o = 1; o < 64; o <<= 1) { const float t = __shfl_up(sc, o); if (lane >= o) sc += t; }
            const float tot = __shfl(sc, 63);
            wgt[tA] = expf(tot - (sc - a1)) * dA; wgt[tB] = expf(tot - sc) * dB;
            if (lane == 63) DEC[((b * 2 + dir) * NCH + c) * 8 + h] = expf(tot);
        }
        v4u xv[4], bv[4];
        { const int tok = tl >> 1, part = tl & 1;
          const v4u* xs = (const v4u*)(XBC + (size_t)(r0 + tok) * 768 + h * 64 + part * 32); const v4u* bs = (const v4u*)(XBC + (size_t)(r0 + tok) * 768 + 512 + g * 64 + part * 32);
#pragma unroll
          for (int q = 0; q < 4; ++q) { xv[q] = xs[q]; bv[q] = bs[q]; } }
        __syncthreads();
        { const int tok = tl >> 1, part = tl & 1; const float w = wgt[tok];
#pragma unroll
          for (int q = 0; q < 4; ++q) { const unsigned xa[4] = {xv[q].x, xv[q].y, xv[q].z, xv[q].w}, ba[4] = {bv[q].x, bv[q].y, bv[q].z, bv[q].w};
#pragma unroll
              for (int e4 = 0; e4 < 4; ++e4) { const int p = part * 32 + q * 8 + e4 * 2;
                  *(bf16*)(XT + p * 272 + tok * 2) = (bf16)f2bf(bflo(xa[e4]) * w); *(bf16*)(XT + (p + 1) * 272 + tok * 2) = (bf16)f2bf(bfhi(xa[e4]) * w);
                  *(bf16*)(BT + p * 272 + tok * 2) = (bf16)(ba[e4] & 0xffffu); *(bf16*)(BT + (p + 1) * 272 + tok * 2) = (bf16)(ba[e4] >> 16); } } }
        __syncthreads();
        { const int pi = wl; bf16* dst = SST + ((size_t)(((b * 2 + dir) * NCH + c) * 8 + h)) * 4096;
#pragma unroll
          for (int ni = 0; ni < 4; ++ni) { f32x4 acc = {0.f, 0.f, 0.f, 0.f};
#pragma unroll
              for (int kk = 0; kk < 4; ++kk) { const bf16x8 af = *(const bf16x8*)(XT + (pi * 16 + (lane & 15)) * 272 + (kk * 32 + 8 * (lane >> 4)) * 2);
                  const bf16x8 bf = *(const bf16x8*)(BT + (ni * 16 + (lane & 15)) * 272 + (kk * 32 + 8 * (lane >> 4)) * 2);
                  acc = __builtin_amdgcn_mfma_f32_16x16x32_bf16(af, bf, acc, 0, 0, 0); }
#pragma unroll
              for (int j = 0; j < 4; ++j) dst[(pi * 16 + 4 * (lane >> 4) + j) * 64 + ni * 16 + (lane & 15)] = (bf16)f2bf(acc[j]); } }
        __syncthreads();
      }
    }
    const bf16* P = (const bf16*)(ows(A) + WS_P); float* S5 = (float*)(ows(A) + WS_S5);
    unsigned char* us = lds + wid * 8320; unsigned char* BuS = us + 4096;
    const int fr = lane & 15, fq = lane >> 4;
    for (int item = obid() * 8 + wid; item < NB * 2 * NCH * 24; item += ogrid() * 8) {
        const int g = item % 24, c = (item / 24) % NCH, dir = (item / (24 * NCH)) & 1, b = item / (48 * NCH);
        float ar, ai; bf16x8 bfr[8]; s5_setup(A, L, dir, g, lane, BuS, ar, ai, bfr);
        s5_stage_u(P, b * TPB + c * 128, g, us, lane);
        float hr = 0.f, hi = 0.f;
#pragma unroll 1
        for (int sb = 0; sb < 8; ++sb) { s5_bu16(us, BuS, dir ? 127 - (sb * 16 + fr) : sb * 16 + fr, bfr, fr, fq);
#pragma unroll
            for (int ii = 0; ii < 16; ++ii) { const unsigned w = *(const unsigned*)(BuS + ii * 264 + lane * 4);
                const float nr = ar * hr - ai * hi + bflo(w), ni = ar * hi + ai * hr + bfhi(w); hr = nr; hi = ni; }
            LDSW(); }
        *(f32x2*)(S5 + ((size_t)(((b * 2 + dir) * NCH + c) * 24 + g) * 64 + lane) * 2) = (f32x2){hr, hi};
    }
}

__device__ __forceinline__ void phase_s2(const Args& A, int L) {
    const int tid = otid();
    bf16* SST = (bf16*)(ows(A) + WS_SST); const float* DEC = (const float*)(ows(A) + WS_DEC);
    for (int gt = obid() * NTHR + tid; gt < NB * 2 * 8 * 2048; gt += ogrid() * NTHR) {
        const int e2 = gt & 2047, h = (gt >> 11) & 7, dir = (gt >> 14) & 1, b = gt >> 15;
        float r0 = 0.f, r1 = 0.f;
#pragma unroll 1
        for (int kb = 0; kb < NCH; kb += 11) { unsigned vv[11]; float dd[11];
#pragma unroll
            for (int q = 0; q < 11; ++q) { const int c = scan_chunk(dir, kb + q); const size_t ci = (size_t)((b * 2 + dir) * NCH + c) * 8 + h; vv[q] = *(const unsigned*)(SST + ci * 4096 + e2 * 2); dd[q] = DEC[ci]; }
#pragma unroll
            for (int q = 0; q < 11; ++q) { const int c = scan_chunk(dir, kb + q); const size_t ci = (size_t)((b * 2 + dir) * NCH + c) * 8 + h;
                *(unsigned*)(SST + ci * 4096 + e2 * 2) = pk2(r0, r1); r0 = r0 * dd[q] + bflo(vv[q]); r1 = r1 * dd[q] + bfhi(vv[q]); } }
    }
    float* S5 = (float*)(ows(A) + WS_S5);
    for (int gt = obid() * NTHR + tid; gt < NB * 2 * 24 * 64; gt += ogrid() * NTHR) {
        const int p = gt & 63, g = (gt >> 6) % 24, dir = (gt / (64 * 24)) & 1, b = gt / (64 * 48);
        const int idx = ((L * 2 + dir) * 24 + g) * 64 + p;
        const float lr = oin(A, 24)[idx], li = oin(A, 25)[idx], step = expf(oin(A, 26)[(L * 2 + dir) * 24 + g]);
        const float mag = expf(lr * step); float s, c0; sincosf(li * step, &s, &c0); float pr = mag * c0, pi = mag * s;
#pragma unroll
        for (int q = 0; q < 7; ++q) { const float nr = pr * pr - pi * pi, ni = 2.f * pr * pi; pr = nr; pi = ni; }
        float hr = 0.f, hi = 0.f;
#pragma unroll 1
        for (int kb = 0; kb < NCH; kb += 11) { f32x2 vv[11];
#pragma unroll
            for (int q = 0; q < 11; ++q) { const int c = scan_chunk(dir, kb + q); vv[q] = *(const f32x2*)(S5 + ((size_t)(((b * 2 + dir) * NCH + c) * 24 + g) * 64 + p) * 2); }
#pragma unroll
            for (int q = 0; q < 11; ++q) { const int c = scan_chunk(dir, kb + q);
                *(f32x2*)(S5 + ((size_t)(((b * 2 + dir) * NCH + c) * 24 + g) * 64 + p) * 2) = (f32x2){hr, hi};
                const float nr = pr * hr - pi * hi + vv[q].x, ni = pr * hi + pi * hr + vv[q].y; hr = nr; hi = ni; } }
    }
}

__device__ __forceinline__ void ssd_out_item(const Args& A, int L, int b, int c, int g, unsigned char* lds) {
    const int tid = otid(), lane = tid & 63, wid = tid >> 6, fr = lane & 15, fq = lane >> 4;
    const bf16* XBC = (const bf16*)(ows(A) + WS_XBC); const float* DT = (const float*)(ows(A) + WS_DT); const bf16* SST = (const bf16*)(ows(A) + WS_SST);
    bf16* P = (bf16*)(ows(A) + WS_P); float* SSQ = (float*)(ows(A) + WS_SSQ);
    float* acum = (float*)lds; float* dtv = (float*)(lds + 4096); unsigned char* XT = lds + 8192; unsigned char* Wst = lds + 8192 + 17408 + wid * 4352;
    const int r0 = b * TPB + c * 128;
    { const int dir = wid >> 2, hh = wid & 3, h = g * 4 + hh; const int t0 = 2 * lane;
        const float d0 = DT[(size_t)(r0 + t0) * 16 + dir * 8 + h], d1 = DT[(size_t)(r0 + t0 + 1) * 16 + dir * 8 + h];
        const float aneg = -expf(oin(A, 11)[L * 16 + dir * 8 + h]); const float a0 = d0 * aneg, a1 = d1 * aneg;
        float sc = a0 + a1;
#pragma unroll
        for (int o = 1; o < 64; o <<= 1) { const float t = __shfl_up(sc, o); if (lane >= o) sc += t; }
        const float tot = __shfl(sc, 63);
        float c0v, c1v;
        if (dir == 0) { c0v = sc - a1; c1v = sc; } else { c0v = tot - (sc - a1) + a0; c1v = tot - sc + a1; }
        acum[wid * 128 + t0] = c0v; acum[wid * 128 + t0 + 1] = c1v; dtv[wid * 128 + t0] = d0; dtv[wid * 128 + t0 + 1] = d1; }
    float ssq[4] = {0.f, 0.f, 0.f, 0.f};
    const int trow = 16 * wid;
    bf16x8 cf[2]; f32x4 G[8];
#pragma unroll
    for (int kk = 0; kk < 2; ++kk) cf[kk] = *(const bf16x8*)(XBC + (size_t)(r0 + trow + fr) * 768 + 640 + g * 64 + kk * 32 + 8 * fq);
#pragma unroll
    for (int si = 0; si < 8; ++si) { G[si] = (f32x4){0.f, 0.f, 0.f, 0.f};
#pragma unroll
        for (int kk = 0; kk < 2; ++kk) { const bf16x8 bfr = *(const bf16x8*)(XBC + (size_t)(r0 + si * 16 + fr) * 768 + 512 + g * 64 + kk * 32 + 8 * fq);
            G[si] = __builtin_amdgcn_mfma_f32_16x16x32_bf16(cf[kk], bfr, G[si], 0, 0, 0); } }
#pragma unroll 1
    for (int hh = 0; hh < 4; ++hh) { const int h = g * 4 + hh;
        __syncthreads();
        { const int tok = tid >> 2, part = tid & 3; const v4u* xs = (const v4u*)(XBC + (size_t)(r0 + tok) * 768 + h * 64 + part * 16);
#pragma unroll
          for (int q = 0; q < 2; ++q) { const v4u xv = xs[q]; const unsigned xa[4] = {xv.x, xv.y, xv.z, xv.w};
#pragma unroll
              for (int e = 0; e < 4; ++e) { const int p = part * 16 + q * 8 + e * 2;
                  *(bf16*)(XT + p * 272 + tok * 2) = (bf16)(xa[e] & 0xffffu); *(bf16*)(XT + (p + 1) * 272 + tok * 2) = (bf16)(xa[e] >> 16); } } }
        unsigned short zv[4][4];
        { const bf16* zq = P + (size_t)(r0 + trow + 4 * fq) * PW + PC_Z + h * 64 + fr;
#pragma unroll
          for (int pi = 0; pi < 4; ++pi)
#pragma unroll
              for (int j = 0; j < 4; ++j) zv[pi][j] = zq[(size_t)j * PW + pi * 16]; }
        __syncthreads();
        f32x4 acc[4];
#pragma unroll
        for (int pi = 0; pi < 4; ++pi) acc[pi] = (f32x4){0.f, 0.f, 0.f, 0.f};
#pragma unroll 1
        for (int dir = 0; dir < 2; ++dir) { const float* ac = acum + (dir * 4 + hh) * 128; const float* dv = dtv + (dir * 4 + hh) * 128;
            const bf16* hs = SST + ((size_t)(((b * 2 + dir) * NCH + c) * 8 + h)) * 4096;
            bf16x8 hf[4][2];
#pragma unroll
            for (int pi = 0; pi < 4; ++pi)
#pragma unroll
                for (int kk = 0; kk < 2; ++kk) hf[pi][kk] = *(const bf16x8*)(hs + (pi * 16 + fr) * 64 + kk * 32 + 8 * fq);
            float at[4];
#pragma unroll
            for (int j = 0; j < 4; ++j) at[j] = ac[trow + 4 * fq + j];
#pragma unroll
            for (int si = 0; si < 8; ++si) { const int s = si * 16 + fr; const float as = ac[s], ds = dv[s];
#pragma unroll
                for (int j = 0; j < 4; ++j) { const int t = trow + 4 * fq + j; const bool ok = dir ? (s >= t) : (s <= t);
                    const float w = ok ? G[si][j] * __expf(at[j] - as) * ds : 0.f;
                    *(bf16*)(Wst + (4 * fq + j) * 272 + s * 2) = (bf16)f2bf(w); } }
            LDSW();
            bf16x8 wf[4];
#pragma unroll
            for (int kk = 0; kk < 4; ++kk) wf[kk] = *(const bf16x8*)(Wst + fr * 272 + (kk * 32 + 8 * fq) * 2);
#pragma unroll
            for (int pi = 0; pi < 4; ++pi) {
#pragma unroll
                for (int kk = 0; kk < 4; ++kk) { const bf16x8 xf = *(const bf16x8*)(XT + (pi * 16 + fr) * 272 + (kk * 32 + 8 * fq) * 2);
                    acc[pi] = __builtin_amdgcn_mfma_f32_16x16x32_bf16(wf[kk], xf, acc[pi], 0, 0, 0); }
                f32x4 yo = {0.f, 0.f, 0.f, 0.f};
#pragma unroll
                for (int kk = 0; kk < 2; ++kk) yo = __builtin_amdgcn_mfma_f32_16x16x32_bf16(cf[kk], hf[pi][kk], yo, 0, 0, 0);
#pragma unroll
                for (int j = 0; j < 4; ++j) acc[pi][j] += __expf(at[j]) * yo[j]; }
            LDSW();
        }
        const float dh = oin(A, 13)[L * 8 + h];
        { bf16* zq = P + (size_t)(r0 + trow + 4 * fq) * PW + PC_Z + h * 64 + fr;
#pragma unroll
          for (int pi = 0; pi < 4; ++pi)
#pragma unroll
              for (int j = 0; j < 4; ++j) { const float x = bf2f(*(const bf16*)(XT + (pi * 16 + fr) * 272 + (trow + 4 * fq + j) * 2)), z = bf2f(zv[pi][j]);
                  const float v = (acc[pi][j] + dh * x) * siluf_(z); ssq[j] += v * v; zq[(size_t)j * PW + pi * 16] = (bf16)f2bf(v); } }
    }
#pragma unroll
    for (int j = 0; j < 4; ++j) { float s = ssq[j]; s += __shfl_xor(s, 1); s += __shfl_xor(s, 2); s += __shfl_xor(s, 4); s += __shfl_xor(s, 8);
        if (fr == 0) SSQ[(size_t)(r0 + trow + 4 * fq + j) * 2 + g] = s; }
    __syncthreads();
}

__device__ __forceinline__ void s5_out_item(const Args& A, int L, int b, int g, int c, unsigned char* wl) {
    const int lane = otid() & 63, fr = lane & 15, fq = lane >> 4;
    bf16* P = (bf16*)(ows(A) + WS_P); const float* S5 = (const float*)(ows(A) + WS_S5);
    unsigned char* us = wl; bf16* yl = (bf16*)(wl + 4096); unsigned char* Hs = wl + 8192; unsigned char* BuS = wl + 12544;
    const int r0 = b * TPB + c * 128;
    s5_stage_u(P, r0, g, us, lane);
    const float dsk = oin(A, 31)[L * 384 + g * 16 + fr];
#pragma unroll 1
    for (int dir = 0; dir < 2; ++dir) {
        float ar, ai; bf16x8 bfr[8]; s5_setup(A, L, dir, g, lane, Hs, ar, ai, bfr);
        const f32x2 h0 = *(const f32x2*)(S5 + ((size_t)(((b * 2 + dir) * NCH + c) * 24 + g) * 64 + lane) * 2);
        float hr = h0.x, hi = h0.y;
        bf16x8 cfr[4];
#pragma unroll
        for (int kk = 0; kk < 4; ++kk) { const int p0 = kk * 16 + 4 * fq;
            const f32x4 cr = *(const f32x4*)(oin(A, 29) + (size_t)((L * 24 + g) * 16 + fr) * 64 + p0), ci = *(const f32x4*)(oin(A, 30) + (size_t)((L * 24 + g) * 16 + fr) * 64 + p0);
            v4u w; w.x = pk2(cr[0], -ci[0]); w.y = pk2(cr[1], -ci[1]); w.z = pk2(cr[2], -ci[2]); w.w = pk2(cr[3], -ci[3]); cfr[kk] = __builtin_bit_cast(bf16x8, w); }
#pragma unroll 1
        for (int sb = 0; sb < 8; ++sb) {
            s5_bu16(us, BuS, dir ? 127 - (sb * 16 + fr) : sb * 16 + fr, bfr, fr, fq);
#pragma unroll
            for (int ii = 0; ii < 16; ++ii) { const unsigned w = *(const unsigned*)(BuS + ii * 264 + lane * 4);
                const float nr = ar * hr - ai * hi + bflo(w), ni = ar * hi + ai * hr + bfhi(w); hr = nr; hi = ni;
                *(unsigned*)(Hs + ii * 272 + lane * 4) = pk2(hr, hi); }
            LDSW();
            f32x4 y = {0.f, 0.f, 0.f, 0.f};
#pragma unroll
            for (int kk = 0; kk < 4; ++kk) { const bf16x8 af = *(const bf16x8*)(Hs + fr * 272 + (kk * 32 + 8 * fq) * 2); y = __builtin_amdgcn_mfma_f32_16x16x32_bf16(af, cfr[kk], y, 0, 0, 0); }
#pragma unroll
            for (int j = 0; j < 4; ++j) { const int i = sb * 16 + 4 * fq + j, tok = dir ? 127 - i : i;
                if (dir == 0) yl[tok * 16 + fr] = (bf16)f2bf(y[j]);
                else { float v = bf2f(yl[tok * 16 + fr]) + y[j] + dsk * bf2f(*(const bf16*)(us + tok * 32 + fr * 2));
                    { const float u_ = 0.7978845608028654f * (v + 0.044715f * v * v * v); v = v * (1.f - __builtin_amdgcn_rcpf(1.f + __expf(2.f * u_))); }
                    P[(size_t)(r0 + tok) * PW + PC_U + g * 16 + fr] = (bf16)f2bf(v); } }
            LDSW();
        }
    }
}

__device__ __forceinline__ void attn_vcu(const Args& A, int L, int v, bool ctx_out, unsigned char* lds) {
    using abf = attn_body::bf16;
    abf* P = (abf*)(ows(A) + WS_P); abf* YB = (abf*)(ows(A) + WS_YB);
    const float lam = ((const float*)(ows(A) + WS_LAM))[L];
    char* shm = (char*)lds;
    const int xcd = v & 7, qb = v >> 3;
#pragma unroll 1
    for (int j = (ctx_out && v < 48) ? 0 : 3; j < 11; ++j) {
        int b, isdiff, m = 0, h = 0, hq = 0, NT = TPB / 64; size_t rq;
        if (j < 3) { b = v / 12; const int kind = v % 12; rq = (size_t)b * TPB; NT = 4;
            if (kind < 4) { if (j == 2) continue; isdiff = 1; m = j; h = kind; } else { if (j > 0) continue; isdiff = 0; hq = kind - 4; } }
        else if (j < 7) { const int i = (j - 3) >> 1, combo = xcd + 8 * i; m = (j - 3) & 1; b = combo >> 2; h = combo & 3; isdiff = 1; rq = (size_t)b * TPB + CTXL + (size_t)qb * 256; }
        else { const int combo = xcd * 4 + (j - 7); b = combo >> 3; hq = combo & 7; isdiff = 0; rq = (size_t)b * TPB + CTXL + (size_t)qb * 256; }
        const size_t rb = (size_t)b * TPB;
#if defined(PROBE_ATTN) && PROBE_ATTN == 2
        if (!isdiff) attn_body::attn_unit<8, 1>(0, P + rq * PW + PC_GQ + hq * 64, P + rb * PW + PC_GK + (hq >> 2) * 64, P + rb * PW + PC_GV + (hq >> 2) * 64, (abf*)(ows(A) + 505 * MiB), 0, NT, 0.f, shm);
#endif
#if defined(PROBE_ATTN) && PROBE_ATTN == 1
        if (isdiff && m == 1) { attn_body::attn_unit<16, 2>(1, P + rq * PW + PC_DQ + (h * 2) * 64, P + rb * PW + PC_DK + (h * 2) * 64, P + rb * PW + PC_DV + h * 128, YB + rq * 512 + h * 128, 512, NT, lam, shm); }
#endif
        if (isdiff) attn_body::attn_unit<16, 2>(1 + m, P + rq * PW + PC_DQ + (h * 2 + m) * 64, P + rb * PW + PC_DK + (h * 2 + m) * 64, P + rb * PW + PC_DV + h * 128, YB + rq * 512 + h * 128, 512, NT, lam, shm);
        else attn_body::attn_unit<8, 1>(0, P + rq * PW + PC_GQ + hq * 64, P + rb * PW + PC_GK + (hq >> 2) * 64, P + rb * PW + PC_GV + (hq >> 2) * 64, P + rq * PW + PC_GQ + hq * 64, PW, NT, 0.f, shm);
    }
}

__device__ __forceinline__ void phase_s3(const Args& A, int L, bool ctx_out, unsigned char* lds) {
    const int c_lo = ctx_out ? 0 : 2, ncs = NCH - c_lo;
    for (int v = obid(); v < 256; v += ogrid()) attn_vcu(A, L, v, ctx_out, lds);
    __syncthreads();
    const int tid = otid(), wid = tid >> 6;
    unsigned* ctr = (unsigned*)(ows(A) + WS_QCTR) + L * 64;
    volatile unsigned* slot = (volatile unsigned*)(lds + LDS_TOTAL - 16);
    const int n_ssd = NB * ncs * 2, n_s5b = NB * 24 * ncs / 8;
    for (;;) {
        if (tid == 0) *slot = __hip_atomic_fetch_add(ctr, 1u, __ATOMIC_RELAXED, __HIP_MEMORY_SCOPE_AGENT);
        __syncthreads();
        const int q = (int)*slot;
        __syncthreads();
        if (q >= n_ssd + n_s5b) break;
        if (q < n_ssd) ssd_out_item(A, L, (q >> 1) / ncs, c_lo + (q >> 1) % ncs, q & 1, lds);
        else { const int item = (q - n_ssd) * 8 + wid; const int c = c_lo + item % ncs, g = (item / ncs) % 24, b = item / (ncs * 24);
            s5_out_item(A, L, b, g, c, lds + wid * 16768); __syncthreads(); }
    }
}

__device__ __forceinline__ void phase_s4(const Args& A, int L, bool ctx_out, unsigned char* lds) {
    const int tid = otid(), lane = tid & 63, wid = tid >> 6;
    bf16* YB = (bf16*)(ows(A) + WS_YB);
    const float lam_init = 0.8f - 0.6f * expf(-0.3f * (float)L);
    const float g0 = oin(A, 21)[L * 128 + 2 * lane] * (1.f - lam_init), g1 = oin(A, 21)[L * 128 + 2 * lane + 1] * (1.f - lam_init);
    const int nw = ogrid() * 8;
    for (int r0 = obid() * 8 + wid; r0 < MALL; r0 += 2 * nw) {
        unsigned vin[2][4]; bool ok[2];
#pragma unroll
        for (int q = 0; q < 2; ++q) { const int r = r0 + q * nw; ok[q] = (r < MALL) && (ctx_out || (r % TPB) >= CTXL); const int rr = (r < MALL) ? r : r0;
#pragma unroll
            for (int h = 0; h < 4; ++h) vin[q][h] = *(const unsigned*)(YB + (size_t)rr * 512 + h * 128 + 2 * lane); }
#pragma unroll
        for (int q = 0; q < 2; ++q)
#pragma unroll
            for (int h = 0; h < 4; ++h) { const float a = bflo(vin[q][h]), b2 = bfhi(vin[q][h]);
                const float rs = rsqrtf(wave_sum(a * a + b2 * b2) * (1.f / 128.f) + EPS);
                if (ok[q]) *(unsigned*)(YB + (size_t)(r0 + q * nw) * 512 + h * 128 + 2 * lane) = pk2(a * rs * g0, b2 * rs * g1); }
    }
    bf16* P = (bf16*)(ows(A) + WS_P);
    int kglu = 384; asm volatile("" : "+s"(kglu));
    pg8::Gemm gm{P + PC_U, (const bf16*)(ows(A) + WS_WT + WT_GLU), kglu, PW}; RSched S; S.init(768, ogrid(), obid(), !ctx_out);
    EpiPair<1> E{P + PC_YD, PW, oin(A, 33) + L * 768, 384};
    pg8::gemm_phase<EpiPair<1>, RSched, true, true>((PG8_LAS unsigned char*)lds, gm, S, E);
}

struct MergeSched {
    RSched S; const bf16* XN; const bf16* WG; const bf16* WB; const bf16* P; const bf16* YB;
    __device__ __forceinline__ bool next(int j, pg8::Unit& u, pg8::Gemm& gm) const {
        if (!S.next(j >> 3, u)) return false;
        const int s8 = j & 7, i = ((s8 >> 2) << 1) | (s8 & 1), kind = (s8 >> 1) & 1, s = 2 * i + kind; u.aux = s;
        if ((s & 1) == 0) { gm.A = XN; gm.Bt = WG + (size_t)i * 1024 * 1024; gm.K = 1024; gm.lda = 1024; }
        else { gm.A = (i == 0) ? (P + PC_Z) : (i == 1) ? YB : (i == 2) ? (P + PC_GQ) : (P + PC_YD); gm.Bt = WB + (size_t)i * 1024 * 512; gm.K = (i == 3) ? 384 : 512; gm.lda = (i == 1) ? 512 : PW; }
        return true;
    }
};
__device__ __forceinline__ void phase_merge(const Args& A, int L, bool ctx_out, unsigned char* lds) {
    bf16* P = (bf16*)(ows(A) + WS_P);
    MergeSched MS; MS.S.init(1024, ogrid(), obid(), !ctx_out);
    MS.XN = (const bf16*)(ows(A) + WS_XN); MS.WG = (const bf16*)(ows(A) + WS_WT + WT_G); MS.WB = (const bf16*)(ows(A) + WS_WT + WT_BR); MS.P = P; MS.YB = (const bf16*)(ows(A) + WS_YB);
    EpiMerge E{(v4u*)(ows(A) + WS_MS + (size_t)obid() * 256 * KiB), (v4u*)(ows(A) + WS_GS + (size_t)obid() * 128 * KiB), P + PC_XM, PW, (const float*)(ows(A) + WS_SSQ)};
    pg8::gemm_phase_h<EpiMerge, MergeSched>((PG8_LAS unsigned char*)lds, MS, E);
}

#define GRID_SYNCW(bw, ord) grid_barrier((unsigned*)(A.ws + WS_XBAR))
#define GRID_SYNC(ord) GRID_SYNCW(0, ord)
#ifdef PROBE_LO
#define PROBE_LO_ PROBE_LO
#else
#define PROBE_LO_ 0
#endif
template <int KSEL, int L, int BW = 0> __device__ __forceinline__ void run_layer(const Args& A, unsigned char* lds, const int ph_lo, const int ph_hi) {
    constexpr bool ctx_out = (L == 0);
#define PH_BEGIN(k) if ((KSEL < 0 || KSEL == (k)) && ph_lo <= 1 + 12 * L + (k) && 1 + 12 * L + (k) < ph_hi) { \
        float* MOD = (float*)(ows(A) + WS_MOD); float* HC = (float*)(ows(A) + WS_HC); bf16* P = (bf16*)(ows(A) + WS_P); const bf16* XN = (const bf16*)(ows(A) + WS_XN); \
        const float* mod = MOD + (size_t)L * 5 * 6144; (void)HC; (void)P; (void)XN; (void)mod;
#define PH_END(k) if (1 + 12 * L + (k) + 1 < ph_hi) GRID_SYNCW(BW, BW == 0 ? 12 * L + (k) + 2 : (k) - PROBE_LO_ + 1); }
    PH_BEGIN(0) if (L != 0 || KSEL >= 0) phase_wconv(A, L, lds); phase_norm(A, L == 0 ? oin(A, 0) : oout(A), L == 0 ? oin(A, 2) : HC, oin(A, 6) + L * 1024, mod, 0, 1024, false); PH_END(0)
    PH_BEGIN(1) { pg8::Gemm gm{XN, (const bf16*)(ows(A) + WS_WT + WT_IN), 1024, 1024}; RSched S; S.init(4096, ogrid(), obid(), false); EpiStore E{P, PW};
        pg8::gemm_phase<EpiStore, RSched, true, true>((PG8_LAS unsigned char*)lds, gm, S, E); } PH_END(1)
    PH_BEGIN(2) phase_prep(A, L); PH_END(2)
    PH_BEGIN(3) phase_s1(A, L, lds); PH_END(3)
    PH_BEGIN(4) phase_s2(A, L); PH_END(4)
    PH_BEGIN(5) phase_s3(A, L, ctx_out, lds); PH_END(5)
    PH_BEGIN(6) phase_s4(A, L, ctx_out, lds); PH_END(6)
    PH_BEGIN(7) phase_merge(A, L, ctx_out, lds); PH_END(7)
    PH_BEGIN(8) { pg8::Gemm gm{P + PC_XM, (const bf16*)(ows(A) + WS_WT + WT_O), 1024, PW}; RSched S; S.init(1024, ogrid(), obid(), !ctx_out);
        EpiRes E{L == 0 ? oin(A, 0) : oout(A), L == 0 ? oin(A, 2) : HC, oout(A), HC, mod, 2048};
        pg8::gemm_phase<EpiRes, RSched, true, true>((PG8_LAS unsigned char*)lds, gm, S, E); } PH_END(8)
    PH_BEGIN(9) phase_norm(A, oout(A), HC, oin(A, 7) + L * 1024, mod, 3072, 4096, !ctx_out); PH_END(9)
    PH_BEGIN(10) { pg8::Gemm gm{XN, (const bf16*)(ows(A) + WS_WT + WT_GU), 1024, 1024}; RSched S; S.init(5632, ogrid(), obid(), !ctx_out);
        EpiPair<0> E{P, FFH, nullptr, 0};
        pg8::gemm_phase<EpiPair<0>, RSched, true, true>((PG8_LAS unsigned char*)lds, gm, S, E); } PH_END(10)
    PH_BEGIN(11) { pg8::Gemm gm{P, (const bf16*)(ows(A) + WS_WT + WT_DN), FFH, FFH}; RSched S; S.init(1024, ogrid(), obid(), !ctx_out);
        EpiRes E{oout(A), HC, oout(A), HC, mod, 5120};
        pg8::gemm_phase<EpiRes, RSched, true, true>((PG8_LAS unsigned char*)lds, gm, S, E); } PH_END(11)
#undef PH_BEGIN
#undef PH_END
}
template <int KSEL> __global__ void __launch_bounds__(NTHR, 2) hybrid_fwd(Args A) {
    extern __shared__ __attribute__((aligned(16))) unsigned char lds[];
    otid_init();
    if (KSEL < 0) { XcdBarrier b0 = xcd_barrier_post((unsigned*)(A.ws + WS_XBAR), (volatile unsigned*)(g_lds_ + LDS_XBST_OFF)); (void)b0; }
    if ((KSEL < 0 || KSEL == 12) && A.ph_lo == 0) { phase_mod(A, lds); if (KSEL < 0) { __syncthreads(); phase_wconv(A, 0, lds); } if (1 < A.ph_hi) GRID_SYNC(1); }
#ifdef PROBE_LO
    run_layer<KSEL, 0>(A, lds, A.ph_lo, 2 + PROBE_HI); GRID_SYNCW(2, 1);
    run_layer<KSEL, 0, 1>(A, lds, 1 + PROBE_LO, 2 + PROBE_HI); GRID_SYNCW(0, PROBE_HI + 2);
    run_layer<KSEL, 0>(A, lds, 2 + PROBE_HI, A.ph_hi);
#else
    run_layer<KSEL, 0>(A, lds, A.ph_lo, A.ph_hi);
#endif
    run_layer<KSEL, 1>(A, lds, A.ph_lo, A.ph_hi);
}

constexpr int N_PHASES = 25;
#ifndef MULTI_LAUNCH
#define MULTI_LAUNCH 0
#endif
template <int KSEL> static bool setup_kernel() {
    return hipFuncSetAttribute((const void*)hybrid_fwd<KSEL>, hipFuncAttributeMaxDynamicSharedMemorySize, LDS_TOTAL) == hipSuccess;
}
template <int KSEL> static void launch_phase(const Args& a, int grid, hipStream_t stream) { hipLaunchKernelGGL(hybrid_fwd<KSEL>, dim3(grid), dim3(NTHR), LDS_TOTAL, stream, a); }
extern "C" void kernel_launch(void* const* d_in, const int* in_sizes, int n_in, void* d_out, int out_size, void* d_ws, size_t ws_size, hipStream_t stream) {
    static int grid = 0;
    if (grid == 0) {
        if (n_in != 42 || ws_size < WS_NEED) { fprintf(stderr, "kernel_launch: unexpected n_in %d / ws %zu\n", n_in, ws_size); grid = -1; return; }
        int dev = 0, cus = 0;
        (void)hipGetDevice(&dev); (void)hipDeviceGetAttribute(&cus, hipDeviceAttributeMultiprocessorCount, dev);
#if MULTI_LAUNCH
        bool ok = setup_kernel<0>() && setup_kernel<1>() && setup_kernel<2>() && setup_kernel<3>() && setup_kernel<4>() && setup_kernel<5>() && setup_kernel<6>() && setup_kernel<7>() &&
                  setup_kernel<8>() && setup_kernel<9>() && setup_kernel<10>() && setup_kernel<11>() && setup_kernel<12>();
#else
        bool ok = setup_kernel<-1>();
#endif
        if (!ok) { fprintf(stderr, "kernel_launch: hipFuncSetAttribute failed\n"); grid = -1; return; }
        (void)hipGetLastError();
        grid = cus;
    }
    if (grid < 0) return;
    Args a{};
    for (int i = 0; i < 42; ++i) a.in[i] = (const float*)d_in[i];
    a.out = (float*)d_out; a.ws = (unsigned char*)d_ws;
#if MULTI_LAUNCH
    for (int ph = 0; ph < N_PHASES; ++ph) { a.ph_lo = ph; a.ph_hi = ph + 1;
        const int k = ph == 0 ? 12 : (ph - 1) % 12;
        switch (k) { case 0: launch_phase<0>(a, grid, stream); break; case 1: launch_phase<1>(a, grid, stream); break; case 2: launch_phase<2>(a, grid, stream); break;
            case 3: launch_phase<3>(a, grid, stream); break; case 4: launch_phase<4>(a, grid, stream); break; case 5: launch_phase<5>(a, grid, stream); break;
            case 6: launch_phase<6>(a, grid, stream); break; case 7: launch_phase<7>(a, grid, stream); break; case 8: launch_phase<8>(a, grid, stream); break;
            case 9: launch_phase<9>(a, grid, stream); break; case 10: launch_phase<10>(a, grid, stream); break; case 11: launch_phase<11>(a, grid, stream); break;
            default: launch_phase<12>(a, grid, stream); break; } }
#else
    a.ph_lo = 0; a.ph_hi = N_PHASES;
    (void)hipMemsetAsync((unsigned char*)d_ws + WS_XBAR, 0, 16384, stream);
    void* args[] = {&a};
    hipError_t e = hipLaunchCooperativeKernel((const void*)hybrid_fwd<-1>, dim3(grid), dim3(NTHR), args, LDS_TOTAL, stream);
    if (e != hipSuccess) fprintf(stderr, "cooperative launch failed: %s (grid %d)\n", hipGetErrorString(e), grid);
#endif
}
```
